# Optimizing an MI355X kernel written in HIP

```python
import math
import jax, jax.numpy as jnp
from jax import lax
import numpy as np


D_MODEL = 1024
BATCH = 16
SEQ = 4096
DEPTH = 1

N_META = 16
BLK = 128
WINDOW = 128
ROPE_THETA = 10000.0
EPS = 1e-6
NEG_INF = -1e30

SWA_HQ = 8
SWA_HKV = 2
SWA_G = SWA_HQ // SWA_HKV
SWA_DH = 64

DIFF_H = 8
DIFF_DQ = 32
DIFF_DV = 2 * DIFF_DQ

IN_WIDTHS = (SWA_HQ * SWA_DH, SWA_HKV * SWA_DH, SWA_HKV * SWA_DH,
             DIFF_H * 2 * DIFF_DQ, DIFF_H * 2 * DIFF_DQ, DIFF_H * DIFF_DV)
IN_WIDTH = 2304
MIX_WIDTH = SWA_HQ * SWA_DH + DIFF_H * DIFF_DV

N_EXPERTS = 32
TOP_K = 4
D_FF = D_MODEL
SWIGLU_LIMIT = 7.0
SWIGLU_ALPHA = 1.702
MOE_BLK = 128

kernel_name = "hymba_swa_sink_diffattn_gptoss_moe"


def _rmsnorm(x, g, eps=EPS):
    xf = x.astype(jnp.float32)
    y = xf * lax.rsqrt(jnp.mean(xf * xf, axis=-1, keepdims=True) + eps)
    return (y * g.astype(jnp.float32)).astype(x.dtype)


def _rope(x, pos):
    d = x.shape[-1]
    inv = ROPE_THETA ** (-jnp.arange(0, d, 2, dtype=jnp.float32) / d)
    ang = pos.astype(jnp.float32)[:, None] * inv[None, :]
    cos = jnp.cos(ang)[None, :, None, :]
    sin = jnp.sin(ang)[None, :, None, :]
    xf = x.astype(jnp.float32)
    x1, x2 = xf[..., : d // 2], xf[..., d // 2:]
    out = jnp.concatenate([x1 * cos - x2 * sin, x2 * cos + x1 * sin], axis=-1)
    return out.astype(x.dtype)


def _band(t):
    pad = [(0, 0)] * t.ndim
    pad[1] = (1, 1)
    tp = jnp.pad(t, pad)
    return jnp.concatenate([tp[:, :-2], tp[:, 1:-1], tp[:, 2:]], axis=2)


def _swa_sink_attention(q, k, v, sink, pos):
    B, L = q.shape[0], q.shape[1]
    P = BLK - N_META
    nb = (L + P) // BLK
    front = ((0, 0), (P, 0), (0, 0), (0, 0))
    qb = jnp.pad(q, front).reshape(B, nb, BLK, SWA_HKV, SWA_G, SWA_DH)
    kb = jnp.pad(k, front).reshape(B, nb, BLK, SWA_HKV, SWA_DH)
    vb = jnp.pad(v, front).reshape(B, nb, BLK, SWA_HKV, SWA_DH)
    k_band, v_band = _band(kb), _band(vb)
    k_meta, v_meta = k[:, :N_META], v[:, :N_META]
    pb = jnp.concatenate([jnp.full((P,), -1, jnp.int32), pos]).reshape(nb, BLK)
    pbp = jnp.pad(pb, ((1, 1), (0, 0)), constant_values=-1)
    p_band = jnp.concatenate([pbp[:-2], pbp[1:-1], pbp[2:]], axis=1)
    band_ok = (p_band[:, None, :] >= N_META) & (jnp.abs(pb[:, :, None] - p_band[:, None, :]) <= WINDOW)
    scale = SWA_DH ** -0.5
    s_meta = jnp.einsum('bnqhgd,bkhd->bnhgqk', qb, k_meta, preferred_element_type=jnp.float32) * scale
    s_band = jnp.einsum('bnqhgd,bnkhd->bnhgqk', qb, k_band, preferred_element_type=jnp.float32) * scale
    s_band = jnp.where(band_ok[None, :, None, None], s_band, NEG_INF)
    s_sink = jnp.broadcast_to(sink.astype(jnp.float32).reshape(1, 1, SWA_HKV, SWA_G, 1, 1),
                              s_meta.shape[:-1] + (1,))
    probs = jax.nn.softmax(jnp.concatenate([s_meta, s_band, s_sink], axis=-1), axis=-1).astype(v.dtype)
    o = (jnp.einsum('bnhgqk,bkhd->bnqhgd', probs[..., :N_META], v_meta)
         + jnp.einsum('bnhgqk,bnkhd->bnqhgd', probs[..., N_META:N_META + 3 * BLK], v_band))
    return o.reshape(B, nb * BLK, SWA_HQ * SWA_DH)[:, P:]


def _diff_attention(q1, q2, k1, k2, v, lam):
    B, L = q1.shape[0], q1.shape[1]
    nq = -(-L // BLK)
    pad_q = ((0, 0), (0, nq * BLK - L), (0, 0), (0, 0))

    def to_blocks(t):
        return jnp.moveaxis(jnp.pad(t, pad_q).reshape(B, nq, BLK, DIFF_H, DIFF_DQ), 1, 0)

    scale = DIFF_DQ ** -0.5

    def one_block(qs):
        a, b = qs
        p1 = jax.nn.softmax(jnp.einsum('bqhd,bkhd->bhqk', a, k1, preferred_element_type=jnp.float32) * scale, axis=-1)
        p2 = jax.nn.softmax(jnp.einsum('bqhd,bkhd->bhqk', b, k2, preferred_element_type=jnp.float32) * scale, axis=-1)
        return jnp.einsum('bhqk,bkhd->bqhd', (p1 - lam * p2).astype(v.dtype), v)

    o = lax.map(one_block, (to_blocks(q1), to_blocks(q2)))
    return jnp.moveaxis(o, 0, 1).reshape(B, nq * BLK, DIFF_H, DIFF_DV)[:, :L]


def _clamped_swiglu(a):
    glu, lin = a[..., :D_FF], a[..., D_FF:]
    glu = jnp.minimum(glu, SWIGLU_LIMIT)
    lin = jnp.clip(lin, -SWIGLU_LIMIT, SWIGLU_LIMIT)
    return glu * jax.nn.sigmoid(SWIGLU_ALPHA * glu) * (lin + 1.0)


def _moe(h, w_router, b_router, w_mlp1, b_mlp1, w_mlp2, b_mlp2):
    T, D = h.shape
    logits = (h @ w_router + b_router).astype(jnp.float32)
    top_val, top_idx = lax.top_k(logits, TOP_K)
    gates = jax.nn.softmax(top_val, axis=-1)
    A = T * TOP_K
    flat_e = top_idx.reshape(A)
    flat_tok = jnp.arange(A, dtype=jnp.int32) // TOP_K
    flat_gate = gates.reshape(A)
    order = jnp.argsort(flat_e)
    e_sorted = flat_e[order]
    counts = jnp.bincount(flat_e, length=N_EXPERTS).astype(jnp.int32)
    padded = (counts + MOE_BLK - 1) // MOE_BLK * MOE_BLK
    pad_end = jnp.cumsum(padded)
    pad_start = pad_end - padded
    start = jnp.cumsum(counts) - counts
    dest = pad_start[e_sorted] + (jnp.arange(A, dtype=jnp.int32) - start[e_sorted])
    n_blocks = -(-A // MOE_BLK) + N_EXPERTS
    n_slots = n_blocks * MOE_BLK
    slot_tok = jnp.full((n_slots,), T, jnp.int32).at[dest].set(flat_tok[order])
    slot_gate = jnp.zeros((n_slots,), jnp.float32).at[dest].set(flat_gate[order])
    block_start = jnp.arange(n_blocks, dtype=jnp.int32) * MOE_BLK
    block_expert = jnp.minimum(jnp.searchsorted(pad_end, block_start, side='right'), N_EXPERTS - 1)
    h_ext = jnp.concatenate([h, jnp.zeros((1, D), h.dtype)], axis=0)
    xs = h_ext[slot_tok].reshape(n_blocks, MOE_BLK, D)

    def expert_block(args):
        xb, e = args
        a = xb @ w_mlp1[e] + b_mlp1[e]
        return _clamped_swiglu(a) @ w_mlp2[e] + b_mlp2[e]

    ys = lax.map(expert_block, (xs, block_expert)).reshape(n_slots, D)
    ys = ys * slot_gate[:, None].astype(ys.dtype)
    return jax.ops.segment_sum(ys, slot_tok, num_segments=T + 1)[:T]


def setup_inputs(seed: int = 0) -> dict:
    key = jax.random.key(seed)
    ks = jax.random.split(key, 24)
    f32 = jnp.float32

    def nrm(k, shape, s):
        return jax.random.normal(k, shape, f32) * s

    def gain(k, shape):
        return 1.0 + 0.05 * jax.random.normal(k, shape, f32)

    return {
        "x": nrm(ks[0], (BATCH, SEQ, D_MODEL), 1.0),
        "meta_tokens": nrm(ks[1], (N_META, D_MODEL), 1.0),
        "g_attn": gain(ks[2], (DEPTH, D_MODEL)),
        "w_in": nrm(ks[3], (DEPTH, D_MODEL, IN_WIDTH), D_MODEL ** -0.5),
        "g_q_swa": gain(ks[4], (DEPTH, SWA_DH)),
        "g_k_swa": gain(ks[5], (DEPTH, SWA_DH)),
        "g_q_diff": gain(ks[6], (DEPTH, DIFF_DQ)),
        "g_k_diff": gain(ks[7], (DEPTH, DIFF_DQ)),
        "sink_swa": nrm(ks[8], (DEPTH, SWA_HQ), 0.5),
        "lambda_q1": nrm(ks[9], (DEPTH, DIFF_DQ), 0.1),
        "lambda_k1": nrm(ks[10], (DEPTH, DIFF_DQ), 0.1),
        "lambda_q2": nrm(ks[11], (DEPTH, DIFF_DQ), 0.1),
        "lambda_k2": nrm(ks[12], (DEPTH, DIFF_DQ), 0.1),
        "g_diff_head": gain(ks[13], (DEPTH, DIFF_DV)),
        "w_out": nrm(ks[14], (DEPTH, MIX_WIDTH, D_MODEL), MIX_WIDTH ** -0.5),
        "g_ffn": gain(ks[15], (DEPTH, D_MODEL)),
        "w_router": nrm(ks[16], (DEPTH, D_MODEL, N_EXPERTS), D_MODEL ** -0.5),
        "b_router": nrm(ks[17], (DEPTH, N_EXPERTS), 0.01),
        "w_mlp1": nrm(ks[18], (DEPTH, N_EXPERTS, D_MODEL, 2 * D_FF), D_MODEL ** -0.5),
        "b_mlp1": nrm(ks[19], (DEPTH, N_EXPERTS, 2 * D_FF), 0.02),
        "w_mlp2": nrm(ks[20], (DEPTH, N_EXPERTS, D_FF, D_MODEL), D_FF ** -0.5),
        "b_mlp2": nrm(ks[21], (DEPTH, N_EXPERTS, D_MODEL), 0.02),
    }


def reference(x, meta_tokens, g_attn, w_in, g_q_swa, g_k_swa, g_q_diff, g_k_diff, sink_swa,
              lambda_q1, lambda_k1, lambda_q2, lambda_k2, g_diff_head, w_out, g_ffn,
              w_router, b_router, w_mlp1, b_mlp1, w_mlp2, b_mlp2):
    B = x.shape[0]
    meta = jnp.broadcast_to(meta_tokens.astype(x.dtype)[None], (B, N_META, D_MODEL))
    h = jnp.concatenate([meta, x], axis=1)
    L = h.shape[1]
    pos = jnp.arange(L, dtype=jnp.int32)
    offs = [0]
    for w in IN_WIDTHS:
        offs.append(offs[-1] + w)
    for l in range(DEPTH):
        lambda_init = 0.8 - 0.6 * math.exp(-0.3 * l)
        u = _rmsnorm(h, g_attn[l])
        proj = u @ w_in[l]
        qa, ka, va, qd, kd, vd = [proj[..., offs[i]:offs[i + 1]] for i in range(6)]
        qa = _rope(_rmsnorm(qa.reshape(B, L, SWA_HQ, SWA_DH), g_q_swa[l]), pos)
        ka = _rope(_rmsnorm(ka.reshape(B, L, SWA_HKV, SWA_DH), g_k_swa[l]), pos)
        va = va.reshape(B, L, SWA_HKV, SWA_DH)
        out_a = _swa_sink_attention(qa, ka, va, sink_swa[l], pos)

        qd = qd.reshape(B, L, DIFF_H, 2, DIFF_DQ)
        kd = kd.reshape(B, L, DIFF_H, 2, DIFF_DQ)
        q1 = _rope(_rmsnorm(qd[..., 0, :], g_q_diff[l]), pos)
        q2 = _rope(_rmsnorm(qd[..., 1, :], g_q_diff[l]), pos)
        k1 = _rope(_rmsnorm(kd[..., 0, :], g_k_diff[l]), pos)
        k2 = _rope(_rmsnorm(kd[..., 1, :], g_k_diff[l]), pos)
        vd = vd.reshape(B, L, DIFF_H, DIFF_DV)
        lam = (jnp.exp(jnp.sum(lambda_q1[l].astype(jnp.float32) * lambda_k1[l].astype(jnp.float32)))
               - jnp.exp(jnp.sum(lambda_q2[l].astype(jnp.float32) * lambda_k2[l].astype(jnp.float32)))
               + lambda_init)
        od = _diff_attention(q1, q2, k1, k2, vd, lam)
        out_b = (_rmsnorm(od, g_diff_head[l], 1e-5) * (1.0 - lambda_init)).reshape(B, L, DIFF_H * DIFF_DV)

        mixed = jnp.concatenate([out_a, out_b], axis=-1)
        h = h + mixed @ w_out[l]
        v = _rmsnorm(h, g_ffn[l]).reshape(B * L, D_MODEL)
        y = _moe(v, w_router[l], b_router[l], w_mlp1[l], b_mlp1[l], w_mlp2[l], b_mlp2[l])
        h = h + y.reshape(B, L, D_MODEL)
    return h[:, N_META:]
```

```cpp
#include <hip/hip_runtime.h>
#include <cstdint>
#include <cstdio>

typedef unsigned short bf16_t;
__device__ __forceinline__ float bf2f(bf16_t b) { return __uint_as_float(((unsigned)b) << 16); }
__device__ __forceinline__ bf16_t f2bf(float f) { unsigned u = __float_as_uint(f); u += 0x7fffu + ((u >> 16) & 1u); return (bf16_t)(u >> 16); }

constexpr int NB = 16, SEQ = 4096, DM = 1024, T = NB * SEQ, NMETA = 16, LPOS = SEQ + NMETA;
constexpr int INW = 2304, NE = 32, TOPK = 4, DFF = 1024;
constexpr int NROWS = T + NMETA;
constexpr float EPS = 1e-6f;
constexpr float LOG2E = 1.4426950408889634f;
constexpr float QSCALE_A = 0.125f * LOG2E;
constexpr float QSCALE_B = 0.17677669529663687f * LOG2E;
constexpr int TILE_EL = 4096;
constexpr int HEAD_EL = SEQ * 64;

constexpr size_t MiB = 1u << 20;
constexpr size_t WS_CTL = 0, CTL_BYTES = 1 * MiB;
constexpr size_t WS_CS64 = 1 * MiB;
constexpr size_t WS_CS32 = 3 * MiB;
constexpr size_t WS_ROT = 3 * MiB + 640 * 1024;
constexpr size_t WS_META = 3 * MiB + 768 * 1024;
constexpr size_t WS_WIN = 4 * MiB, WS_WOUT = 9 * MiB;
constexpr size_t WS_RSTD = 11 * MiB;
constexpr size_t WS_WRT = 11 * MiB + 512 * 1024;
constexpr size_t WS_EXTOK = 12 * MiB, WS_EXGATE = 20 * MiB;
constexpr size_t WS_W2T = 32 * MiB;
constexpr size_t WS_ACT = 96 * MiB;
constexpr size_t WS_QA = WS_ACT, WS_KA = WS_QA + (size_t)NB * 8 * HEAD_EL * 2, WS_VA = WS_KA + (size_t)NB * 2 * HEAD_EL * 2;
constexpr size_t WS_QB = WS_VA + (size_t)NB * 2 * HEAD_EL * 2, WS_KB = WS_QB + (size_t)NB * 8 * HEAD_EL * 2, WS_VB = WS_KB + (size_t)NB * 8 * HEAD_EL * 2;
constexpr size_t WS_X = 624 * MiB;
constexpr size_t WS_W1T = WS_X, WS_V = WS_X + 128 * MiB, WS_MIXED = WS_X + 256 * MiB;
constexpr size_t WS_XB = 400 * MiB;
constexpr size_t WS_YS3 = WS_X;
constexpr size_t WS_END = 1024 * MiB;
static_assert(WS_VB + (size_t)NB * 8 * HEAD_EL * 2 <= WS_XB && WS_XB + (size_t)T * DM * 2 <= WS_X, "qkv / xb fit");
constexpr int CW_COUNT = 64;

struct P {
    const float *x, *meta, *g_attn, *w_in, *g_q_swa, *g_k_swa, *g_q_diff, *g_k_diff, *sink, *lq1, *lk1, *lq2, *lk2, *g_dh, *w_out, *g_ffn, *w_router, *b_router, *w1, *b1, *w2, *b2;
    float* out; unsigned char* ws;
};

__host__ __device__ __forceinline__ int ktile_off(int tok, int d) { return (tok >> 6) * TILE_EL + (d >> 3) * 512 + (tok & 63) * 8 + (d & 7); }
__host__ __device__ __forceinline__ int vtile_off(int tok, int d) { return (tok >> 6) * TILE_EL + (d >> 5) * 2048 + ((tok & 63) >> 4) * 512 + (tok & 15) * 32 + (d & 31); }

__host__ __device__ __forceinline__ int bslot(int dp) { return 8 * ((dp & 15) >> 2) + 4 * (dp >> 4) + (dp & 3); }
__global__ void k_tables(P p) {
    float2* cs64 = (float2*)(p.ws + WS_CS64); float2* cs32 = (float2*)(p.ws + WS_CS32);
    const int i = blockIdx.x * blockDim.x + threadIdx.x;
    if (i < LPOS * 32) { const int pos = i >> 5, f = i & 31; const float inv = powf(10000.0f, -(float)(2 * f) / 64.0f); const float ang = (float)pos * inv; cs64[i] = make_float2(cosf(ang), sinf(ang)); }
    if (i < LPOS * 16) { const int pos = i >> 4, f = i & 15; const float inv = powf(10000.0f, -(float)(2 * f) / 32.0f); const float ang = (float)pos * inv; cs32[i] = make_float2(cosf(ang), sinf(ang)); }
    if (i < 20 * TILE_EL / 2) ((unsigned*)(p.ws + WS_META))[i] = 0u;
}
__global__ void k_rstd(P p) {
    const int row = blockIdx.x * (blockDim.x >> 6) + (threadIdx.x >> 6), lane = threadIdx.x & 63;
    if (row >= NROWS) return;
    const float* xr = row < T ? p.x + (size_t)row * DM : p.meta + (size_t)(row - T) * DM;
    float s = 0.f;
    for (int j = 0; j < 4; ++j) { const float4 v = ((const float4*)xr)[lane + 64 * j]; s += v.x * v.x + v.y * v.y + v.z * v.z + v.w * v.w; }
    for (int o = 1; o < 64; o <<= 1) s += __shfl_xor(s, o);
    if (lane == 0) ((float*)(p.ws + WS_RSTD))[row] = rsqrtf(s * (1.0f / DM) + EPS);
}

__device__ __forceinline__ void headpost(const P& p, int r, int hc, float* v, const float2* cs64, const float2* cs32) {
    const bool meta = r >= T; const int b = r >> 12, tok = r & 4095, pos = meta ? r - T : tok + NMETA;
    bf16_t* QA = (bf16_t*)(p.ws + WS_QA); bf16_t* KA = (bf16_t*)(p.ws + WS_KA); bf16_t* VA = (bf16_t*)(p.ws + WS_VA);
    bf16_t* QB = (bf16_t*)(p.ws + WS_QB); bf16_t* KB = (bf16_t*)(p.ws + WS_KB); bf16_t* VB = (bf16_t*)(p.ws + WS_VB);
    bf16_t* MT = (bf16_t*)(p.ws + WS_META);
    if (hc < 10) {
        if (hc < 8 && meta) return;
        const float* g = hc < 8 ? p.g_q_swa : p.g_k_swa;
        float ss = 0.f; for (int d = 0; d < 64; ++d) ss += v[d] * v[d];
        const float rs = rsqrtf(ss * (1.0f / 64.0f) + EPS);
        for (int d = 0; d < 64; ++d) v[d] = v[d] * rs * g[d];
        for (int i = 0; i < 32; ++i) { const float2 cs = cs64[i]; const float a = v[i], c = v[i + 32]; v[i] = a * cs.x - c * cs.y; v[i + 32] = c * cs.x + a * cs.y; }
        if (hc < 8) { bf16_t* q = QA + ((size_t)(b * 8 + hc) * SEQ + tok) * 64; for (int d = 0; d < 64; ++d) q[d] = f2bf(v[d] * QSCALE_A); }
        else { const int kvh = hc - 8; bf16_t* k = meta ? MT + kvh * TILE_EL : KA + (size_t)(b * 2 + kvh) * HEAD_EL; const int tk = meta ? pos : tok; for (int d = 0; d < 64; ++d) k[ktile_off(tk, d)] = f2bf(v[d]); }
    } else if (hc < 12) {
        const int kvh = hc - 10; bf16_t* vv = meta ? MT + (2 + kvh) * TILE_EL : VA + (size_t)(b * 2 + kvh) * HEAD_EL; const int tk = meta ? pos : tok;
        for (int d = 0; d < 64; ++d) vv[vtile_off(tk, d)] = f2bf(v[d]);
    } else if (hc < 28) {
        const bool isq = hc < 20; if (isq && meta) return;
        const float* g = isq ? p.g_q_diff : p.g_k_diff;
        for (int hf = 0; hf < 2; ++hf) { float* w = v + 32 * hf;
            float ss = 0.f; for (int d = 0; d < 32; ++d) ss += w[d] * w[d];
            const float rs = rsqrtf(ss * (1.0f / 32.0f) + EPS);
            for (int d = 0; d < 32; ++d) w[d] = w[d] * rs * g[d];
            for (int i = 0; i < 16; ++i) { const float2 cs = cs32[i]; const float a = w[i], c = w[i + 16]; w[i] = a * cs.x - c * cs.y; w[i + 16] = c * cs.x + a * cs.y; } }
        if (isq) { const int h = hc - 12; bf16_t* q = QB + ((size_t)(b * 8 + h) * SEQ + tok) * 64; for (int d = 0; d < 64; ++d) q[(d & 32) + bslot(d & 31)] = f2bf(v[d] * QSCALE_B); }
        else { const int h = hc - 20; bf16_t* k = meta ? MT + (4 + h) * TILE_EL : KB + (size_t)(b * 8 + h) * HEAD_EL; const int tk = meta ? pos : tok; for (int d = 0; d < 64; ++d) k[ktile_off(tk, (d & 32) + bslot(d & 31))] = f2bf(v[d]); }
    } else {
        const int h = hc - 28; bf16_t* vv = meta ? MT + (12 + h) * TILE_EL : VB + (size_t)(b * 8 + h) * HEAD_EL; const int tk = meta ? pos : tok;
        for (int d = 0; d < 64; ++d) vv[vtile_off(tk, d)] = f2bf(v[d]);
    }
}

__global__ __launch_bounds__(256) void k_inproj_naive(P p) {
    __shared__ float As[16][68], Bs[16][68], Ct[64][65];
    const int tid = threadIdx.x, tx = tid & 15, ty = tid >> 4, r0 = blockIdx.x * 64, hc = blockIdx.y;
    const float* rstd = (const float*)(p.ws + WS_RSTD);
    float acc[4][4] = {};
    for (int k0 = 0; k0 < DM; k0 += 16) {
        for (int i = 0; i < 4; ++i) { const int idx = tid + i * 256, rr = idx >> 4, kk = idx & 15, r = r0 + rr; float a = 0.f;
            if (r < NROWS) { const float* xr = r < T ? p.x + (size_t)r * DM : p.meta + (size_t)(r - T) * DM; a = xr[k0 + kk] * rstd[r] * p.g_attn[k0 + kk]; }
            As[kk][rr] = a; }
        for (int i = 0; i < 4; ++i) { const int idx = tid + i * 256, kk = idx >> 6, cc = idx & 63; Bs[kk][cc] = p.w_in[(size_t)(k0 + kk) * INW + hc * 64 + cc]; }
        __syncthreads();
        for (int kk = 0; kk < 16; ++kk) { float a[4], bb[4];
            for (int i = 0; i < 4; ++i) a[i] = As[kk][ty * 4 + i];
            for (int j = 0; j < 4; ++j) bb[j] = Bs[kk][tx * 4 + j];
            for (int i = 0; i < 4; ++i) for (int j = 0; j < 4; ++j) acc[i][j] += a[i] * bb[j]; }
        __syncthreads();
    }
    for (int i = 0; i < 4; ++i) for (int j = 0; j < 4; ++j) Ct[ty * 4 + i][tx * 4 + j] = acc[i][j];
    __syncthreads();
    if (tid < 64) { const int r = r0 + tid; if (r < NROWS) { const int pos = r >= T ? r - T : (r & 4095) + NMETA; headpost(p, r, hc, &Ct[tid][0], (const float2*)(p.ws + WS_CS64) + pos * 32, (const float2*)(p.ws + WS_CS32) + pos * 16); } }
}

__global__ __launch_bounds__(256) void k_swa_naive(P p) {
    const int gid = blockIdx.x * 256 + threadIdx.x; const int tok = gid & 4095, bh = gid >> 12, hq = bh & 7, b = bh >> 3, kvh = hq >> 2;
    const bf16_t* QA = (const bf16_t*)(p.ws + WS_QA) + ((size_t)bh * SEQ + tok) * 64;
    const bf16_t* KA = (const bf16_t*)(p.ws + WS_KA) + (size_t)(b * 2 + kvh) * HEAD_EL; const bf16_t* VA = (const bf16_t*)(p.ws + WS_VA) + (size_t)(b * 2 + kvh) * HEAD_EL;
    const bf16_t* MT = (const bf16_t*)(p.ws + WS_META); const bf16_t* KM = MT + kvh * TILE_EL; const bf16_t* VM = MT + (2 + kvh) * TILE_EL;
    float q[64], o[64]; for (int d = 0; d < 64; ++d) { q[d] = bf2f(QA[d]); o[d] = 0.f; }
    float l = exp2f(p.sink[hq] * LOG2E);
    for (int k = 0; k < NMETA; ++k) { float s = 0.f; for (int d = 0; d < 64; ++d) s += q[d] * bf2f(KM[ktile_off(k, d)]); const float pr = exp2f(s); l += pr; for (int d = 0; d < 64; ++d) o[d] += pr * bf2f(VM[vtile_off(k, d)]); }
    const int k0 = tok - 128 < 0 ? 0 : tok - 128, k1 = tok + 128 > SEQ - 1 ? SEQ - 1 : tok + 128;
    for (int k = k0; k <= k1; ++k) { float s = 0.f; for (int d = 0; d < 64; ++d) s += q[d] * bf2f(KA[ktile_off(k, d)]); const float pr = exp2f(s); l += pr; for (int d = 0; d < 64; ++d) o[d] += pr * bf2f(VA[vtile_off(k, d)]); }
    bf16_t* mx = (bf16_t*)(p.ws + WS_MIXED) + ((size_t)b * SEQ + tok) * DM + hq * 64; const float il = 1.0f / l;
    for (int d = 0; d < 64; ++d) mx[d] = f2bf(o[d] * il);
}
__global__ __launch_bounds__(256) void k_diff_naive(P p) {
    __shared__ float Ks[64][64]; __shared__ float Vs[64][64];
    const int unit = blockIdx.x, qb = unit & 15, bh = unit >> 4, h = bh & 7, b = bh >> 3, tid = threadIdx.x, tok = qb * 256 + tid;
    const bf16_t* QB = (const bf16_t*)(p.ws + WS_QB) + ((size_t)bh * SEQ + tok) * 64;
    const bf16_t* KB = (const bf16_t*)(p.ws + WS_KB) + (size_t)bh * HEAD_EL; const bf16_t* VB = (const bf16_t*)(p.ws + WS_VB) + (size_t)bh * HEAD_EL;
    const bf16_t* MT = (const bf16_t*)(p.ws + WS_META);
    float q[64], o1[64], o2[64]; for (int d = 0; d < 64; ++d) { q[d] = bf2f(QB[d]); o1[d] = 0.f; o2[d] = 0.f; }
    float l1 = 0.f, l2 = 0.f;
    for (int t = 0; t < 65; ++t) {
        const bf16_t* kt = t < 64 ? KB + t * TILE_EL : MT + (4 + h) * TILE_EL; const bf16_t* vt = t < 64 ? VB + t * TILE_EL : MT + (12 + h) * TILE_EL; const int nk = t < 64 ? 64 : NMETA;
        __syncthreads();
        for (int i = 0; i < 16; ++i) { const int e = tid + i * 256;
            Ks[(e >> 3) & 63][(e >> 9) * 8 + (e & 7)] = bf2f(kt[e]);
            Vs[((e >> 9) & 3) * 16 + ((e >> 5) & 15)][(e >> 11) * 32 + (e & 31)] = bf2f(vt[e]); }
        __syncthreads();
        for (int k = 0; k < nk; ++k) { float s1 = 0.f, s2 = 0.f;
            for (int d = 0; d < 32; ++d) { s1 += q[d] * Ks[k][d]; s2 += q[32 + d] * Ks[k][32 + d]; }
            const float p1 = exp2f(s1), p2 = exp2f(s2); l1 += p1; l2 += p2;
            for (int d = 0; d < 64; ++d) { const float vv = Vs[k][d]; o1[d] += p1 * vv; o2[d] += p2 * vv; } }
    }
    float sa = 0.f, sb = 0.f; for (int d = 0; d < 32; ++d) { sa += p.lq1[d] * p.lk1[d]; sb += p.lq2[d] * p.lk2[d]; }
    const float lam = expf(sa) - expf(sb) + 0.2f; const float i1 = 1.0f / l1, i2 = lam / l2;
    float ss = 0.f; for (int d = 0; d < 64; ++d) { o1[d] = o1[d] * i1 - o2[d] * i2; ss += o1[d] * o1[d]; }
    const float rs = rsqrtf(ss * (1.0f / 64.0f) + 1e-5f) * 0.8f;
    bf16_t* mx = (bf16_t*)(p.ws + WS_MIXED) + ((size_t)b * SEQ + tok) * DM + 512 + h * 64;
    for (int d = 0; d < 64; ++d) mx[d] = f2bf(o1[d] * rs * p.g_dh[d]);
}

__device__ __forceinline__ void expert_of_panel(const unsigned* counts, int panel, int& e, int& pos0, int& cnt) {
    int ps = 0; e = -1; pos0 = 0; cnt = 0;
    for (int i = 0; i < NE; ++i) { const int c = (int)counts[i], np = (c + 255) >> 8; if (panel < ps + np) { e = i; pos0 = (panel - ps) * 256; cnt = c; return; } ps += np; }
}

template <int MODE> __global__ __launch_bounds__(256) void k_sgemm(P p) {
    __shared__ float As[16][68], Bs[16][68], Bs2[16][68];
    __shared__ int rowtok[64]; __shared__ float rowgate[64];
    const int tid = threadIdx.x, tx = tid & 15, ty = tid >> 4, r0 = blockIdx.x * 64, c0 = blockIdx.y * 64;
    const unsigned* counts = (const unsigned*)(p.ws + WS_CTL) + CW_COUNT;
    int e = 0, pos0 = 0, cnt = 0;
    if (MODE != 0) { expert_of_panel(counts, blockIdx.x >> 2, e, pos0, cnt); if (e < 0) return; pos0 += (blockIdx.x & 3) * 64;
        if (tid < 64) { const int pos = pos0 + tid; const bool ok = pos < cnt; rowtok[tid] = ok ? ((const int*)(p.ws + WS_EXTOK))[e * 65536 + pos] : -1; rowgate[tid] = ok ? ((const float*)(p.ws + WS_EXGATE))[e * 65536 + pos] : 0.f; }
        __syncthreads(); }
    const bf16_t* Amix = (const bf16_t*)(p.ws + WS_MIXED); const bf16_t* Av = (const bf16_t*)(p.ws + WS_V); const bf16_t* Aact = (const bf16_t*)(p.ws + WS_ACT);
    float acc[4][4] = {}, acc2[4][4] = {};
    for (int k0 = 0; k0 < DM; k0 += 16) {
        for (int i = 0; i < 4; ++i) { const int idx = tid + i * 256, rr = idx >> 4, kk = idx & 15; float a = 0.f;
            if (MODE == 0) a = bf2f(Amix[(size_t)(r0 + rr) * DM + k0 + kk]);
            if (MODE == 1) { const int tk = rowtok[rr]; a = tk >= 0 ? bf2f(Av[(size_t)(tk >> 2) * DM + k0 + kk]) : 0.f; }
            if (MODE == 2) a = bf2f(Aact[(size_t)(r0 + rr) * DM + k0 + kk]);
            As[kk][rr] = a; }
        for (int i = 0; i < 4; ++i) { const int idx = tid + i * 256, kk = idx >> 6, cc = idx & 63;
            if (MODE == 0) Bs[kk][cc] = p.w_out[(size_t)(k0 + kk) * DM + c0 + cc];
            if (MODE == 1) { const float* w = p.w1 + (size_t)e * DM * 2048 + (size_t)(k0 + kk) * 2048 + c0 + cc; Bs[kk][cc] = w[0]; Bs2[kk][cc] = w[1024]; }
            if (MODE == 2) Bs[kk][cc] = p.w2[(size_t)e * DM * DM + (size_t)(k0 + kk) * DM + c0 + cc]; }
        __syncthreads();
        for (int kk = 0; kk < 16; ++kk) { float a[4], bb[4], b2[4];
            for (int i = 0; i < 4; ++i) a[i] = As[kk][ty * 4 + i];
            for (int j = 0; j < 4; ++j) { bb[j] = Bs[kk][tx * 4 + j]; if (MODE == 1) b2[j] = Bs2[kk][tx * 4 + j]; }
            for (int i = 0; i < 4; ++i) for (int j = 0; j < 4; ++j) { acc[i][j] += a[i] * bb[j]; if (MODE == 1) acc2[i][j] += a[i] * b2[j]; } }
        __syncthreads();
    }
    for (int i = 0; i < 4; ++i) for (int j = 0; j < 4; ++j) { const int rr = ty * 4 + i, r = r0 + rr, c = c0 + tx * 4 + j;
        if (MODE == 0) p.out[(size_t)r * DM + c] = p.x[(size_t)r * DM + c] + acc[i][j];
        if (MODE == 1) { float glu = acc[i][j] + p.b1[e * 2048 + c], lin = acc2[i][j] + p.b1[e * 2048 + 1024 + c];
            glu = fminf(glu, 7.0f); lin = fminf(fmaxf(lin, -7.0f), 7.0f);
            const float a = glu * (1.0f / (1.0f + __expf(-1.702f * glu))) * (lin + 1.0f);
            ((bf16_t*)(p.ws + WS_ACT))[(size_t)r * DM + c] = f2bf(a); }
        if (MODE == 2) { const int tk = rowtok[rr]; if (tk >= 0) { const float y = (acc[i][j] + p.b2[e * DM + c]) * rowgate[rr]; const int tok = tk >> 2, k = tk & 3;
            if (k == 0) p.out[(size_t)tok * DM + c] += y; else ((bf16_t*)(p.ws + WS_YS3))[((size_t)tok * 3 + (k - 1)) * DM + c] = f2bf(y); } }
    }
}

template <bool OH> __device__ __forceinline__ void route_block(const P& p, int t0, int ntok, int* lhist  , int* lbase  , int* lsel  , float* lgate  , float* lrow  ) {
    const int tid = threadIdx.x, lane = tid & 63, wid = tid >> 6, nw = blockDim.x >> 6;
    unsigned* counts = (unsigned*)(p.ws + WS_CTL) + CW_COUNT;
    if (tid < NE) lhist[tid] = 0;
    __syncthreads();
    bf16_t* V = (bf16_t*)(p.ws + WS_V);
    for (int it = wid; it < ntok; it += nw) {
        const int tok = t0 + it; const float* hr = OH ? p.x + (size_t)tok * DM : p.out + (size_t)tok * DM;
        float4 v[4]; float s = 0.f;
        for (int j = 0; j < 4; ++j) { v[j] = ((const float4*)hr)[lane + 64 * j];
            if (OH) { const uint2 w = ((const uint2*)((const bf16_t*)p.out + (size_t)tok * 2048))[lane + 64 * j];
                v[j].x += __uint_as_float(w.x << 16); v[j].y += __uint_as_float(w.x & 0xffff0000u); v[j].z += __uint_as_float(w.y << 16); v[j].w += __uint_as_float(w.y & 0xffff0000u); }
            s += v[j].x * v[j].x + v[j].y * v[j].y + v[j].z * v[j].z + v[j].w * v[j].w; }
        for (int o = 1; o < 64; o <<= 1) s += __shfl_xor(s, o);
        const float rs = rsqrtf(s * (1.0f / DM) + EPS);
        for (int j = 0; j < 4; ++j) { const float4 g = ((const float4*)p.g_ffn)[lane + 64 * j]; v[j].x *= rs * g.x; v[j].y *= rs * g.y; v[j].z *= rs * g.z; v[j].w *= rs * g.w;
            ushort4 w; w.x = f2bf(v[j].x); w.y = f2bf(v[j].y); w.z = f2bf(v[j].z); w.w = f2bf(v[j].w); ((ushort4*)(V + (size_t)tok * DM))[lane + 64 * j] = w; }
        float* row = lrow + wid * DM;
#pragma unroll
        for (int j = 0; j < 4; ++j) ((float4*)row)[lane + 64 * j] = v[j];
        __builtin_amdgcn_fence(__ATOMIC_RELEASE, "workgroup"); __builtin_amdgcn_wave_barrier();
        float acc = 0.f; { const int e = lane & 31, kb = (lane >> 5) * 512; const float* wr = p.w_router + (size_t)kb * NE + e;
#pragma unroll 8
            for (int k = 0; k < 512; ++k) acc += row[kb + k] * wr[(size_t)k * NE]; }
        acc += __shfl_xor(acc, 32);
        __builtin_amdgcn_wave_barrier();
        const float mylogit = lane < NE ? acc + p.b_router[lane] : -INFINITY;
        float cur = mylogit; float tv0 = 0.f, tv1 = 0.f, tv2 = 0.f, tv3 = 0.f; int ti0 = 0, ti1 = 0, ti2 = 0, ti3 = 0;
#pragma unroll
        for (int k = 0; k < TOPK; ++k) { float bv = cur; int bi = lane;
#pragma unroll
            for (int o = 1; o < 64; o <<= 1) { const float ov = __shfl_xor(bv, o); const int oi = __shfl_xor(bi, o); if (ov > bv || (ov == bv && oi < bi)) { bv = ov; bi = oi; } }
            if (k == 0) { tv0 = bv; ti0 = bi; } if (k == 1) { tv1 = bv; ti1 = bi; } if (k == 2) { tv2 = bv; ti2 = bi; } if (k == 3) { tv3 = bv; ti3 = bi; }
            if (lane == bi) cur = -INFINITY; }
        const float e0 = 1.0f, e1 = __expf(tv1 - tv0), e2 = __expf(tv2 - tv0), e3 = __expf(tv3 - tv0); const float inv = 1.0f / (e0 + e1 + e2 + e3);
        if (lane < 4) { const int sel = lane == 0 ? ti0 : lane == 1 ? ti1 : lane == 2 ? ti2 : ti3; const float gg = (lane == 0 ? e0 : lane == 1 ? e1 : lane == 2 ? e2 : e3) * inv;
            lsel[it * 4 + lane] = sel; lgate[it * 4 + lane] = gg; atomicAdd(&lhist[sel], 1); }
    }
    __syncthreads();
    if (tid < NE) { lbase[tid] = (int)atomicAdd(&counts[tid], (unsigned)lhist[tid]); lhist[tid] = 0; }
    __syncthreads();
    int* extok = (int*)(p.ws + WS_EXTOK); float* exgate = (float*)(p.ws + WS_EXGATE);
    for (int i = tid; i < ntok * 4; i += blockDim.x) { const int e = lsel[i]; const int pos = lbase[e] + atomicAdd(&lhist[e], 1);
        extok[e * 65536 + pos] = (t0 + (i >> 2)) * 4 + (i & 3); exgate[e * 65536 + pos] = lgate[i]; }
    __syncthreads();
}
__global__ __launch_bounds__(256) void k_route(P p) {
    __shared__ int lhist[32], lbase[32], lsel[64 * 4]; __shared__ float lgate[64 * 4]; __shared__ float lrow[4 * DM];
    route_block<false>(p, blockIdx.x * 64, 64, lhist, lbase, lsel, lgate, lrow);
}
__global__ __launch_bounds__(256) void k_combine(P p) {
    const size_t i = (size_t)blockIdx.x * 256 + threadIdx.x;
    const size_t tok = i >> 8, c4 = i & 255; const bf16_t* ys = (const bf16_t*)(p.ws + WS_YS3) + tok * 3 * DM + c4 * 4;
    float4 o = ((float4*)p.out)[i];
    for (int k = 0; k < 3; ++k) { const ushort4 w = *(const ushort4*)(ys + (size_t)k * DM); o.x += bf2f(w.x); o.y += bf2f(w.y); o.z += bf2f(w.z); o.w += bf2f(w.w); }
    ((float4*)p.out)[i] = o;
}


#define LAS __attribute__((address_space(3)))
#define GAS __attribute__((address_space(1)))
typedef short bf16x8 __attribute__((ext_vector_type(8)));
typedef float f32x4 __attribute__((ext_vector_type(4)));
typedef unsigned u32x4 __attribute__((ext_vector_type(4)));
typedef unsigned u32x2 __attribute__((ext_vector_type(2)));
typedef int v4i_t __attribute__((ext_vector_type(4)));
typedef int v8i_t __attribute__((ext_vector_type(8)));

#ifndef OPT_INPROJ
#define OPT_INPROJ 1
#endif
#ifndef OPT_ATTN
#define OPT_ATTN 1
#endif
#ifndef OPT_OUTPROJ
#define OPT_OUTPROJ 1
#endif
#ifndef OPT_ROUTE
#define OPT_ROUTE 1
#endif
#ifndef OPT_MOE
#define OPT_MOE 1
#endif
#ifndef OPT_COMBINE
#define OPT_COMBINE 1
#endif
#ifndef ONE_LAUNCH
#define ONE_LAUNCH 1
#endif

constexpr int RING_OFF = 0, RING_BYTES = 131072;
constexpr int LDSCTL_OFF = RING_BYTES, MISC_OFF = LDSCTL_OFF + 320;
constexpr int TAB_OFF = LDSCTL_OFF + 512;
constexpr int TAB_PSTART = TAB_OFF, TAB_CNT = TAB_OFF + 160, TAB_PEXP = TAB_OFF + 320, TAB_GOFF = TAB_OFF + 2048;
constexpr int LDS_BYTES = 151552;
constexpr int TAB_EPI = TAB_GOFF + 8192, EP_BUF = 3072;
static_assert(TAB_PEXP + 1280 <= TAB_GOFF && TAB_EPI + 2 * EP_BUF <= LDS_BYTES, "LDS map");
constexpr int NWAVES = 8;
constexpr int CW_BAR = 4096;

__device__ __forceinline__ int fresh_lane() { unsigned z = 0u; asm volatile("" : "+v"(z)); return (int)__builtin_amdgcn_mbcnt_hi(~0u, __builtin_amdgcn_mbcnt_lo(~0u, z)); }
__device__ __forceinline__ float shx(float v, int m, int lane) { return __int_as_float(__builtin_amdgcn_ds_bpermute((lane ^ m) << 2, __float_as_int(v))); }
__device__ __forceinline__ int shxi(int v, int m, int lane) { return __builtin_amdgcn_ds_bpermute((lane ^ m) << 2, v); }
template <int CTRL> __device__ __forceinline__ float dppf(float v) { return __int_as_float(__builtin_amdgcn_mov_dpp(__float_as_int(v), CTRL, 0xf, 0xf, true)); }
__device__ __forceinline__ float allsum32(float s) {
    s += dppf<0xB1>(s); s += dppf<0x4E>(s); s += dppf<0x141>(s); s += dppf<0x140>(s);
    const auto r = __builtin_amdgcn_permlane16_swap((unsigned)__float_as_int(s), (unsigned)__float_as_int(s), false, false);
    return __int_as_float((int)r[0]) + __int_as_float((int)r[1]); }
__device__ __forceinline__ float sum4rows(float s) {
    const auto r = __builtin_amdgcn_permlane16_swap((unsigned)__float_as_int(s), (unsigned)__float_as_int(s), false, false); s = __int_as_float((int)r[0]) + __int_as_float((int)r[1]);
    const auto q = __builtin_amdgcn_permlane32_swap((unsigned)__float_as_int(s), (unsigned)__float_as_int(s), false, false); return __int_as_float((int)q[0]) + __int_as_float((int)q[1]); }
__device__ __forceinline__ float allsum64(float s) { s = allsum32(s);
    const auto q = __builtin_amdgcn_permlane32_swap((unsigned)__float_as_int(s), (unsigned)__float_as_int(s), false, false);
    return __int_as_float((int)q[0]) + __int_as_float((int)q[1]); }
__device__ __forceinline__ float allmax32(float s) {
    s = fmaxf(s, dppf<0xB1>(s)); s = fmaxf(s, dppf<0x4E>(s)); s = fmaxf(s, dppf<0x141>(s)); s = fmaxf(s, dppf<0x140>(s));
    const auto r = __builtin_amdgcn_permlane16_swap((unsigned)__float_as_int(s), (unsigned)__float_as_int(s), false, false);
    return fmaxf(__int_as_float((int)r[0]), __int_as_float((int)r[1])); }
namespace pg8 {
constexpr int BM = 256, BK = 64, HALF = 128, HTB = HALF * BK * 2, STAGE_BYTES = 8 * HTB, NXCD = 8, WGM = 8, K = 1024;
__host__ __device__ __forceinline__ int lds_byte(int r, int c) { const int st = (r >> 4) * 2 + (c >> 5), rr = r & 15, cc = c & 31, ob = rr * 64 + cc * 2; return st * 1024 + (ob ^ (((ob >> 9) & 1) << 5)); }
__host__ __device__ __forceinline__ void stage_rc(int b, int& R, int& C) { const int st = b / 1024, sb = b % 1024, swz = sb ^ (((sb >> 9) & 1) << 5); R = (st >> 1) * 16 + swz / 64; C = (st & 1) * 32 + (swz % 64) / 2; }
__host__ __device__ __forceinline__ int perm32(int rho) { const int n = rho >> 4, i = rho & 15; return 8 * (i >> 2) + 4 * n + (i & 3); }
__device__ __forceinline__ unsigned cvt_pk_bf16(float lo, float hi) { unsigned r; asm volatile("v_cvt_pk_bf16_f32 %0, %1, %2" : "=v"(r) : "v"(lo), "v"(hi)); return r; }

struct Unit { int pm, pn, e, pos0, cnt; };

template <int PITCH_> struct RowOrderT {
    static constexpr int PITCH = PITCH_;
    static constexpr bool GATHERS = false;
    int nM, nN, nwg, G, c; const char* A; const char* Bt;
    __device__ void init(int M, int N, int G_, int c_, const void* A_, const void* Bt_) { nM = M / BM; nN = N / BM; nwg = nM * nN; G = G_; c = c_; A = (const char*)A_; Bt = (const char*)Bt_; }
    __device__ __forceinline__ bool next(int i, Unit& u) const {
        const long L = (long)i * G + c; if (L >= nwg) return false;
        int wgid = (int)L; { const int q = nwg / NXCD, r = nwg % NXCD, xcd = wgid % NXCD, off = wgid / NXCD; wgid = (xcd < r ? xcd * (q + 1) : r * (q + 1) + (xcd - r) * q) + off; }
        const int nig = WGM * nN, gid = wgid / nig, fm = gid * WGM, gsz = (nM - fm) < WGM ? (nM - fm) : WGM;
        u.pm = fm + ((wgid % nig) % gsz); u.pn = (wgid % nig) / gsz; u.e = 0; u.pos0 = 0; u.cnt = 0; return true;
    }
    __device__ __forceinline__ const char* aptr(const Unit& u) const { return A + (size_t)u.pm * (BM * PITCH); }
    __device__ __forceinline__ const char* bptr(const Unit& u) const { return Bt + (size_t)u.pn * (BM * PITCH); }
    __device__ __forceinline__ void a_offsets(const Unit&, int, unsigned (&)[2][2]) const {}
};
typedef RowOrderT<K * 2> RowOrder; typedef RowOrderT<K> RowOrder8;
template <int NC, bool GATHER> struct MoeOrder {
    static constexpr int PITCH = K;
    static constexpr bool GATHERS = GATHER;
    int G, vcu, npan; const char* A; const char* Bt; size_t estride; const int* extok;
    const LAS int* pstart; const LAS int* cnts; const LAS unsigned char* pexp;
    __device__ __forceinline__ bool next(int i, Unit& u) const {
        const int U = i * G + vcu, panel = U / NC; if (panel >= npan) return false;
        const int e = __builtin_amdgcn_readfirstlane((int)pexp[panel]);
        u.pm = panel; u.pn = U % NC; u.e = e; u.pos0 = (panel - __builtin_amdgcn_readfirstlane(pstart[e])) * 256; u.cnt = __builtin_amdgcn_readfirstlane(cnts[e]); return true;
    }
    __device__ __forceinline__ const char* aptr(const Unit& u) const { return GATHER ? A : A + (size_t)u.pm * (BM * PITCH); }
    __device__ __forceinline__ const char* bptr(const Unit& u) const { return Bt + (size_t)u.e * estride + (size_t)u.pn * (BM * PITCH); }
    __device__ __forceinline__ void a_offsets(const Unit& u, int wid, unsigned (&o)[2][2]) const {
        int R0, C0; stage_rc((wid * 64 + fresh_lane()) * 16, R0, C0);
#pragma unroll
        for (int h = 0; h < 2; ++h)
#pragma unroll
            for (int i = 0; i < 2; ++i) {
                if (GATHER) { int pos = u.pos0 + R0 + 64 * i + 128 * h; pos = pos < u.cnt ? pos : u.cnt - 1; const int tk = extok[u.e * 65536 + pos]; o[h][i] = (unsigned)(tk >> 2) * (unsigned)PITCH + (unsigned)C0 * 2u; }
                else o[h][i] = (unsigned)((R0 + 64 * i + 128 * h) * PITCH + C0 * 2); }
    }
};

template <class E, class = void> struct UsesTab { static constexpr bool V = false; };
template <class E> struct UsesTab<E, decltype((void)E::USES_TAB)> { static constexpr bool V = E::USES_TAB; };
template <class E, class = void> struct AccBias { static constexpr bool V = false; };
template <class E> struct AccBias<E, decltype((void)E::ACC_BIAS)> { static constexpr bool V = E::ACC_BIAS; };
template <class Epi, class Sched>
__device__ __forceinline__ void gemm_phase(LAS unsigned char* lds, const Sched& S, const Epi& E, const int wid) {
    const int lane = fresh_lane(), tid = wid * 64 + lane, wr = wid >> 2, wc = wid & 3, fr = lane & 15, fq = lane >> 4;
    constexpr int PITCH = Sched::PITCH; constexpr bool FP8 = (PITCH == K); constexpr int nt = PITCH / 128;
    unsigned voffB[2]; int R0 = 0, C0 = 0;
#pragma unroll
    for (int i = 0; i < 2; ++i) { int R, C; stage_rc(tid * 16 + i * 8192, R, C); const int Rb = Epi::PERM ? ((R & ~31) + perm32(R & 31)) : R;
        voffB[i] = (unsigned)(Rb * PITCH + C * 2); if (i == 0) { R0 = R; C0 = C; } }
    const unsigned voffA0 = (unsigned)(R0 * PITCH + C0 * 2);
    const size_t kstep = (size_t)(BK * 2);
    const size_t hstep = (size_t)HALF * PITCH;
    const unsigned ldsw = (unsigned)wid * 1024u; const unsigned lbase_ = (unsigned)__builtin_amdgcn_readfirstlane((int)(unsigned)(__SIZE_TYPE__)lds);
    const int aoff = lds_byte(wr * 64 + fr, fq * 8), boff = lds_byte(wc * 32 + fr, fq * 8);
#define PG8_SA(b, h) (((b) * 2 + (h)) * HTB)
#define PG8_SB(b, h) ((4 + (b) * 2 + (h)) * HTB)
#define PG8_GLDS(gbase, voff, ldsaddr) do { unsigned keep_; const unsigned long long b_ = (unsigned long long)(gbase); \
        const unsigned long long bu_ = ((unsigned long long)(unsigned)__builtin_amdgcn_readfirstlane((int)(unsigned)(b_ >> 32)) << 32) | (unsigned)__builtin_amdgcn_readfirstlane((int)(unsigned)b_); \
        asm volatile("s_mov_b32 %0, m0\n\ts_mov_b32 m0, %2\n\ts_nop 0\n\tglobal_load_lds_dwordx4 %1, %3\n\ts_mov_b32 m0, %0" : "=&s"(keep_) : "v"(voff), "s"(ldsaddr), "s"(bu_) : "memory"); } while (0)
#define PG8_GLDS4(gbase, voff, ldsaddr) do { unsigned keep_; const unsigned long long b_ = (unsigned long long)(gbase); \
        const unsigned long long bu_ = ((unsigned long long)(unsigned)__builtin_amdgcn_readfirstlane((int)(unsigned)(b_ >> 32)) << 32) | (unsigned)__builtin_amdgcn_readfirstlane((int)(unsigned)b_); \
        asm volatile("s_mov_b32 %0, m0\n\ts_mov_b32 m0, %2\n\ts_nop 0\n\tglobal_load_lds_dword %1, %3\n\ts_mov_b32 m0, %0" : "=&s"(keep_) : "v"(voff), "s"(ldsaddr), "s"(bu_) : "memory"); } while (0)
#define PG8_STAGE2S(bufoff, gbase, o0) do { const unsigned la_ = lbase_ + (unsigned)(bufoff) + ldsw; \
        PG8_GLDS(gbase, o0, la_); PG8_GLDS((const char*)(gbase) + 64 * PITCH, o0, la_ + 8192u); } while (0)
#define PG8_STAGE2(bufoff, gbase, o0, o1) do { const unsigned la_ = lbase_ + (unsigned)(bufoff) + ldsw; \
        PG8_GLDS(gbase, o0, la_); PG8_GLDS(gbase, o1, la_ + 8192u); } while (0)
#define PG8_STAGE_B(bufoff, gbase) PG8_STAGE2S(bufoff, gbase, voffB[0])
#define PG8_STAGE_A(bufoff, gbase, off, h) do { if constexpr (Sched::GATHERS) PG8_STAGE2(bufoff, gbase, off[h][0], off[h][1]); \
        else PG8_STAGE2S(bufoff, (const char*)(gbase) + (h) * hstep, voffA0); } while (0)
#define PG8_LDA(dst, b, h) do { _Pragma("unroll") for (int m = 0; m < 4; ++m) { const v4i_t lo_ = *(const LAS v4i_t*)(lds + PG8_SA(b, h) + aoff + m * 2048), hi_ = *(const LAS v4i_t*)(lds + PG8_SA(b, h) + aoff + m * 2048 + 1024); \
        dst[m] = __builtin_shufflevector(lo_, hi_, 0, 1, 2, 3, 4, 5, 6, 7); } } while (0)
#define PG8_LDB(dst, b, h) do { _Pragma("unroll") for (int n = 0; n < 2; ++n) { const v4i_t lo_ = *(const LAS v4i_t*)(lds + PG8_SB(b, h) + boff + n * 2048), hi_ = *(const LAS v4i_t*)(lds + PG8_SB(b, h) + boff + n * 2048 + 1024); \
        dst[n] = __builtin_shufflevector(lo_, hi_, 0, 1, 2, 3, 4, 5, 6, 7); } } while (0)
#define PG8_LO(x) __builtin_bit_cast(bf16x8, __builtin_shufflevector(x, x, 0, 1, 2, 3))
#define PG8_HI(x) __builtin_bit_cast(bf16x8, __builtin_shufflevector(x, x, 4, 5, 6, 7))
#define PG8_MMA(ai, bj, At, Bt) do { __builtin_amdgcn_s_setprio(1); _Pragma("unroll") for (int m = 0; m < 4; ++m) _Pragma("unroll") for (int n = 0; n < 2; ++n) { \
        if constexpr (FP8) acc[ai][bj][m][n] = __builtin_amdgcn_mfma_scale_f32_16x16x128_f8f6f4(Bt[n], At[m], acc[ai][bj][m][n], 0, 0, 0, (int)Epi::SCALE_W, 0, (int)Epi::SCALE_A); \
        else { acc[ai][bj][m][n] = __builtin_amdgcn_mfma_f32_16x16x32_bf16(PG8_LO(Bt[n]), PG8_LO(At[m]), acc[ai][bj][m][n], 0, 0, 0); acc[ai][bj][m][n] = __builtin_amdgcn_mfma_f32_16x16x32_bf16(PG8_HI(Bt[n]), PG8_HI(At[m]), acc[ai][bj][m][n], 0, 0, 0); } } \
        __builtin_amdgcn_s_setprio(0); } while (0)
#define PG8_WAIT_V(n) asm volatile("s_waitcnt vmcnt(" #n ")" ::: "memory")
#define PG8_WAIT_L(n) asm volatile("s_waitcnt lgkmcnt(" #n ")" ::: "memory")
#define PG8_BAR __builtin_amdgcn_s_barrier()
#define PG8_SCHED __builtin_amdgcn_sched_barrier(0)
    Unit cur, nxt; int ui = 0;
    if (!S.next(0, cur)) return;
    unsigned gc[2][2], gn[2][2];
    if constexpr (Sched::GATHERS) S.a_offsets(cur, wid, gc);
    f32x4 acc[2][2][4][2];
#pragma unroll
    for (int a = 0; a < 2; ++a)
#pragma unroll
        for (int b = 0; b < 2; ++b)
#pragma unroll
            for (int m = 0; m < 4; ++m)
#pragma unroll
                for (int n = 0; n < 2; ++n) acc[a][b][m][n] = (f32x4){0.f, 0.f, 0.f, 0.f};
    if constexpr (AccBias<Epi>::V) E.acc_init(acc, cur, wc, fq);
    v8i_t At[4], B0[2], B1[2];
    const char* cA = S.aptr(cur); const char* cB = S.bptr(cur);
#define PG8_EPI_PREFETCH(U, PAR) do { if constexpr (Epi::HAS_PREFETCH) { const unsigned eb_ = lbase_ + (unsigned)(TAB_EPI - RING_OFF) + (unsigned)(PAR) * EP_BUF + (unsigned)(wid & 3) * 256u; \
        const unsigned lo_ = (unsigned)((wid & 3) * 64 + fresh_lane()) * 4u;     \
        if (wid < 4) { PG8_GLDS4(E.tk_base(U), lo_, eb_); PG8_GLDS4(E.gate_base(U), lo_, eb_ + 1024u); } \
        else PG8_GLDS4(E.bias_base(U), lo_, eb_ + 2048u); } } while (0)
    PG8_EPI_PREFETCH(cur, 0);
    PG8_STAGE_B(PG8_SB(0, 0), cB); PG8_STAGE_B(PG8_SB(0, 1), cB + hstep); PG8_STAGE_A(PG8_SA(0, 0), cA, gc, 0); PG8_STAGE_A(PG8_SA(0, 1), cA, gc, 1);
    if (wr == 1) PG8_BAR;
    PG8_WAIT_V(2); PG8_BAR;
    PG8_STAGE_B(PG8_SB(1, 0), cB + kstep); PG8_STAGE_A(PG8_SA(1, 0), cA + kstep, gc, 0); PG8_STAGE_B(PG8_SB(1, 1), cB + hstep + kstep);
    PG8_WAIT_V(6); PG8_BAR;
    for (;;) {
        const bool has_next = S.next(ui + 1, nxt);
        const char* nA = has_next ? S.aptr(nxt) : cA; const char* nB = has_next ? S.bptr(nxt) : cB;
        if constexpr (Sched::GATHERS) {
            if (has_next) S.a_offsets(nxt, wid, gn);
            else {
#pragma unroll
                for (int h = 0; h < 2; ++h)
#pragma unroll
                    for (int i = 0; i < 2; ++i) gn[h][i] = gc[h][i]; }
            *(LAS u32x4*)(lds + (TAB_GOFF - RING_OFF) + tid * 16) = (u32x4){gn[0][0], gn[0][1], gn[1][0], gn[1][1]}; }
#pragma unroll 1
        for (int t = 0; t < nt; t += 2) {
            const bool last = (t == nt - 2);
            const char* a1 = cA + (size_t)(t + 1) * kstep;
            const char* a2 = last ? nA : cA + (size_t)(t + 2) * kstep; const char* b2 = last ? nB : cB + (size_t)(t + 2) * kstep;
            const char* a3 = a2 + kstep; const char* b3 = b2 + kstep;
            unsigned o2[2][2];
            if constexpr (Sched::GATHERS) {
#pragma unroll
                for (int h = 0; h < 2; ++h)
#pragma unroll
                    for (int i = 0; i < 2; ++i) o2[h][i] = gc[h][i];
                if (last) { const u32x4 g_ = *(const LAS u32x4*)(lds + (TAB_GOFF - RING_OFF) + tid * 16); o2[0][0] = g_.x; o2[0][1] = g_.y; o2[1][0] = g_.z; o2[1][1] = g_.w; } }
            PG8_LDB(B0, 0, 0); PG8_LDB(B1, 0, 1); PG8_SCHED; PG8_LDA(At, 0, 0); PG8_STAGE_A(PG8_SA(1, 1), a1, gc, 1);
            PG8_WAIT_V(8); PG8_WAIT_L(0); PG8_BAR; PG8_MMA(0, 0, At, B0); PG8_MMA(0, 1, At, B1); PG8_BAR; PG8_SCHED;
            PG8_LDA(At, 0, 1); PG8_STAGE_B(PG8_SB(0, 0), b2); PG8_STAGE_B(PG8_SB(0, 1), b2 + hstep); PG8_STAGE_A(PG8_SA(0, 0), a2, o2, 0);
            PG8_WAIT_V(8); PG8_WAIT_L(0); PG8_BAR; PG8_MMA(1, 0, At, B0); PG8_MMA(1, 1, At, B1); PG8_BAR; PG8_SCHED;
            PG8_LDB(B0, 1, 0); PG8_LDB(B1, 1, 1); PG8_SCHED; PG8_LDA(At, 1, 0); PG8_STAGE_A(PG8_SA(0, 1), a2, o2, 1);
            PG8_WAIT_V(8); PG8_WAIT_L(0); PG8_BAR; PG8_MMA(0, 0, At, B0); PG8_MMA(0, 1, At, B1); PG8_BAR; PG8_SCHED;
            PG8_LDA(At, 1, 1); PG8_STAGE_B(PG8_SB(1, 0), b3); PG8_STAGE_B(PG8_SB(1, 1), b3 + hstep); PG8_STAGE_A(PG8_SA(1, 0), a3, o2, 0);
            PG8_WAIT_V(8); PG8_WAIT_L(0); PG8_BAR; PG8_MMA(1, 0, At, B0); PG8_MMA(1, 1, At, B1); PG8_BAR; PG8_SCHED;
        }
        if (wr == 0) PG8_BAR;
        { const int le_ = fresh_lane();
          if constexpr (AccBias<Epi>::V) E.run_acc(acc, cur, nxt, has_next, wr, wc, le_ & 15, le_ >> 4);
          else if constexpr (Epi::HAS_PREFETCH) E.run(acc, cur, wr, wc, le_ & 15, le_ >> 4, lds + (TAB_EPI - RING_OFF) + (ui & 1) * EP_BUF);
          else if constexpr (UsesTab<Epi>::V) E.run_tab(acc, cur, wr, wc, le_ & 15, le_ >> 4, lds + (TAB_EPI - RING_OFF)); else E(acc, cur, wr, wc, le_ & 15, le_ >> 4); }
        if (!has_next) break;
        if constexpr (!AccBias<Epi>::V) {
#pragma unroll
        for (int a = 0; a < 2; ++a)
#pragma unroll
            for (int b = 0; b < 2; ++b)
#pragma unroll
                for (int m = 0; m < 4; ++m)
#pragma unroll
                    for (int n = 0; n < 2; ++n) acc[a][b][m][n] = (f32x4){0.f, 0.f, 0.f, 0.f}; }
        cur = nxt; cA = nA; cB = nB; ++ui;
        PG8_EPI_PREFETCH(cur, ui & 1);
        if constexpr (Sched::GATHERS) { const u32x4 g_ = *(const LAS u32x4*)(lds + (TAB_GOFF - RING_OFF) + tid * 16); gc[0][0] = g_.x; gc[0][1] = g_.y; gc[1][0] = g_.z; gc[1][1] = g_.w; }
        if (wr == 1) PG8_BAR;
    }
    PG8_WAIT_V(0);
    PG8_BAR;
#undef PG8_SA
#undef PG8_SB
#undef PG8_STAGE2
#undef PG8_STAGE2S
#undef PG8_GLDS
#undef PG8_GLDS4
#undef PG8_STAGE_A
#undef PG8_EPI_PREFETCH
#undef PG8_STAGE_B
#undef PG8_LDA
#undef PG8_LDB
#undef PG8_MMA
#undef PG8_LO
#undef PG8_HI
#undef PG8_WAIT_V
#undef PG8_WAIT_L
#undef PG8_BAR
#undef PG8_SCHED
}

typedef float f32x2 __attribute__((ext_vector_type(2)));
#define PK2(V, I) ((f32x2){V[I], V[(I) + 1]})
struct EpiQKV {
    static constexpr bool PERM = true; static constexpr bool HAS_PREFETCH = false; static constexpr bool USES_TAB = true;
    __device__ __forceinline__ void operator()(const f32x4 (&)[2][2][4][2], const Unit&, int, int, int, int) const {} static constexpr unsigned SCALE_W = 0x7f7f7f7fu, SCALE_A = 0x7f7f7f7fu; const P* pp;
    __device__ __forceinline__ void run_tab(const f32x4 (&acc)[2][2][4][2], const Unit& u, int wr, int wc, int fr, int fq, const LAS unsigned char* ep) const {
        const P& p = *pp; const int hc = u.pn * 4 + wc; const int b = u.pm >> 4, tokb = (u.pm & 15) * 256 + wr * 64 + fr, lane = fq * 16 + fr;
        const LAS float* tab = (const LAS float*)ep; const float posf = (float)(tokb + NMETA);
        if (hc < 10) {
            const LAS float* g = tab + (hc < 8 ? 0 : 64); f32x4 gv[2][2];
#pragma unroll
            for (int bj = 0; bj < 2; ++bj)
#pragma unroll
                for (int n = 0; n < 2; ++n) gv[bj][n] = *(const LAS f32x4*)(g + 32 * bj + 8 * fq + 4 * n);
            f32x2 co[4], si[4], rc[4], rsn[4];
            { const LAS f32x4* rr = (const LAS f32x4*)(tab + 192 + 16 * fq); const LAS f32x4* iv = (const LAS f32x4*)(tab + 288 + 8 * fq);
#pragma unroll
              for (int q = 0; q < 4; ++q) { const f32x4 r4 = rr[q]; rc[q] = (f32x2){r4[0], r4[2]}; rsn[q] = (f32x2){r4[1], r4[3]}; }
#pragma unroll
              for (int q = 0; q < 2; ++q) { const f32x4 i4 = iv[q];
#pragma unroll
                  for (int j = 0; j < 4; ++j) { const float xr = __builtin_amdgcn_fractf(posf * i4[j]); co[2 * q + (j >> 1)][j & 1] = __builtin_amdgcn_cosf(xr); si[2 * q + (j >> 1)][j & 1] = __builtin_amdgcn_sinf(xr); } } }
            bf16_t* dst = hc < 8 ? (bf16_t*)(p.ws + WS_QA) + (size_t)(b * 8 + hc) * HEAD_EL : (bf16_t*)(p.ws + WS_KA) + (size_t)(b * 2 + (hc - 8)) * HEAD_EL;
            const float osc = hc < 8 ? QSCALE_A : 1.0f;
#pragma unroll
            for (int ai = 0; ai < 2; ++ai) {
#pragma unroll
                for (int m = 0; m < 4; ++m) { const int tok = tokb + 128 * ai + 16 * m;
                    f32x2 sq[2];
#pragma unroll
                    for (int bj = 0; bj < 2; ++bj) { const f32x4 x = acc[ai][bj][m][0], y = acc[ai][bj][m][1]; sq[bj] = PK2(x, 0) * PK2(x, 0); sq[bj] += PK2(x, 2) * PK2(x, 2); sq[bj] += PK2(y, 0) * PK2(y, 0); sq[bj] += PK2(y, 2) * PK2(y, 2); }
                    const f32x2 sq2 = sq[0] + sq[1];
                    const float ss = sum4rows(sq2[0] + sq2[1]);
                    const float rs = __builtin_amdgcn_rsqf(ss * (1.0f / 64.0f) + EPS) * osc;
                    float o0[8], o1[8];
#pragma unroll
                    for (int n = 0; n < 2; ++n) { const f32x4 y0 = acc[ai][0][m][n] * rs * gv[0][n], y1 = acc[ai][1][m][n] * rs * gv[1][n];
#pragma unroll
                        for (int j = 0; j < 4; j += 2) { const f32x2 c = co[2 * n + (j >> 1)], s_ = si[2 * n + (j >> 1)], a0 = PK2(y0, j), a1 = PK2(y1, j); const f32x2 r0 = a0 * c - a1 * s_, r1 = a1 * c + a0 * s_;
                            o0[4 * n + j] = r0[0]; o0[4 * n + j + 1] = r0[1]; o1[4 * n + j] = r1[0]; o1[4 * n + j + 1] = r1[1]; } }
                    u32x4 w0, w1; w0.x = cvt_pk_bf16(o0[0], o0[1]); w0.y = cvt_pk_bf16(o0[2], o0[3]); w0.z = cvt_pk_bf16(o0[4], o0[5]); w0.w = cvt_pk_bf16(o0[6], o0[7]);
                    w1.x = cvt_pk_bf16(o1[0], o1[1]); w1.y = cvt_pk_bf16(o1[2], o1[3]); w1.z = cvt_pk_bf16(o1[4], o1[5]); w1.w = cvt_pk_bf16(o1[6], o1[7]);
                    if (hc < 8) { bf16_t* q = dst + (size_t)tok * 64 + 8 * fq; *(u32x4*)q = w0; *(u32x4*)(q + 32) = w1; }
                    else { bf16_t* k = dst + (tok >> 6) * TILE_EL + (tok & 63) * 8 + fq * 512; *(u32x4*)k = w0; *(u32x4*)(k + 4 * 512) = w1; }
#pragma unroll
                    for (int i = 0; i < 4; ++i) { const f32x2 c2 = co[i] * rc[i] - si[i] * rsn[i], s2 = si[i] * rc[i] + co[i] * rsn[i]; co[i] = c2; si[i] = s2; } }
#pragma unroll
                for (int k4 = 0; k4 < 4; ++k4)
#pragma unroll
                    for (int i = 0; i < 4; ++i) { const f32x2 c2 = co[i] * rc[i] - si[i] * rsn[i], s2 = si[i] * rc[i] + co[i] * rsn[i]; co[i] = c2; si[i] = s2; } }
        } else if (hc < 12 || hc >= 28) {
            bf16_t* dst = hc < 12 ? (bf16_t*)(p.ws + WS_VA) + (size_t)(b * 2 + (hc - 10)) * HEAD_EL : (bf16_t*)(p.ws + WS_VB) + (size_t)(b * 8 + (hc - 28)) * HEAD_EL;
#pragma unroll
            for (int ai = 0; ai < 2; ++ai)
#pragma unroll
                for (int m = 0; m < 4; ++m) { const int tok = tokb + 128 * ai + 16 * m; bf16_t* v = dst + (tok >> 6) * TILE_EL + ((tok & 63) >> 4) * 512 + (tok & 15) * 32 + 8 * fq;
#pragma unroll
                    for (int bj = 0; bj < 2; ++bj) { const f32x4 x0 = acc[ai][bj][m][0], x1 = acc[ai][bj][m][1]; u32x4 w; w.x = cvt_pk_bf16(x0[0], x0[1]); w.y = cvt_pk_bf16(x0[2], x0[3]); w.z = cvt_pk_bf16(x1[0], x1[1]); w.w = cvt_pk_bf16(x1[2], x1[3]);
                        *(u32x4*)(v + bj * 2048) = w; } }
        } else {
            const bool isq = hc < 20; const LAS float* g = tab + (isq ? 128 : 160); f32x4 gv[2];
#pragma unroll
            for (int n = 0; n < 2; ++n) gv[n] = *(const LAS f32x4*)(g + 4 * fq + 16 * n);
            f32x2 co[2], si[2], rc[2], rsn[2];
            { const LAS f32x4* rr = (const LAS f32x4*)(tab + 256 + 8 * fq); const f32x4 i4 = *(const LAS f32x4*)(tab + 320 + 4 * fq);
#pragma unroll
              for (int q = 0; q < 2; ++q) { const f32x4 r4 = rr[q]; rc[q] = (f32x2){r4[0], r4[2]}; rsn[q] = (f32x2){r4[1], r4[3]}; }
#pragma unroll
              for (int j = 0; j < 4; ++j) { const float xr = __builtin_amdgcn_fractf(posf * i4[j]); co[j >> 1][j & 1] = __builtin_amdgcn_cosf(xr); si[j >> 1][j & 1] = __builtin_amdgcn_sinf(xr); } }
            bf16_t* dst = isq ? (bf16_t*)(p.ws + WS_QB) + (size_t)(b * 8 + (hc - 12)) * HEAD_EL : (bf16_t*)(p.ws + WS_KB) + (size_t)(b * 8 + (hc - 20)) * HEAD_EL;
            const float osc = isq ? QSCALE_B : 1.0f;
#pragma unroll
            for (int ai = 0; ai < 2; ++ai) {
#pragma unroll
                for (int m = 0; m < 4; ++m) { const int tok = tokb + 128 * ai + 16 * m;
#pragma unroll
                    for (int bj = 0; bj < 2; ++bj) { const f32x4 x0 = acc[ai][bj][m][0], x1 = acc[ai][bj][m][1];
                        f32x2 sqa = PK2(x0, 0) * PK2(x0, 0), sqb = PK2(x1, 0) * PK2(x1, 0); sqa += PK2(x0, 2) * PK2(x0, 2); sqb += PK2(x1, 2) * PK2(x1, 2); const f32x2 sq2 = sqa + sqb;
                        const float ss = sum4rows(sq2[0] + sq2[1]);
                        const float rs = __builtin_amdgcn_rsqf(ss * (1.0f / 32.0f) + EPS) * osc;
                        const f32x4 y0 = x0 * rs * gv[0], y1 = x1 * rs * gv[1]; float o0[4], o1[4];
#pragma unroll
                        for (int j = 0; j < 4; j += 2) { const f32x2 c = co[j >> 1], s_ = si[j >> 1], a0 = PK2(y0, j), a1 = PK2(y1, j); const f32x2 r0 = a0 * c - a1 * s_, r1 = a1 * c + a0 * s_; o0[j] = r0[0]; o0[j + 1] = r0[1]; o1[j] = r1[0]; o1[j + 1] = r1[1]; }
                        u32x4 w; w.x = cvt_pk_bf16(o0[0], o0[1]); w.y = cvt_pk_bf16(o0[2], o0[3]); w.z = cvt_pk_bf16(o1[0], o1[1]); w.w = cvt_pk_bf16(o1[2], o1[3]);
                        if (isq) *(u32x4*)(dst + (size_t)tok * 64 + 32 * bj + 8 * fq) = w;
                        else *(u32x4*)(dst + (tok >> 6) * TILE_EL + (tok & 63) * 8 + (4 * bj + fq) * 512) = w; }
#pragma unroll
                    for (int i = 0; i < 2; ++i) { const f32x2 c2 = co[i] * rc[i] - si[i] * rsn[i], s2 = si[i] * rc[i] + co[i] * rsn[i]; co[i] = c2; si[i] = s2; } }
#pragma unroll
                for (int k4 = 0; k4 < 4; ++k4)
#pragma unroll
                    for (int i = 0; i < 2; ++i) { const f32x2 c2 = co[i] * rc[i] - si[i] * rsn[i], s2 = si[i] * rc[i] + co[i] * rsn[i]; co[i] = c2; si[i] = s2; } }
        }
    }
};
struct EpiO {
    static constexpr bool PERM = true; static constexpr bool HAS_PREFETCH = false; static constexpr unsigned SCALE_W = 0x7f7f7f7fu, SCALE_A = 0x7f7f7f7fu; bf16_t* ob;
    __device__ __forceinline__ void operator()(const f32x4 (&acc)[2][2][4][2], const Unit& u, int wr, int wc, int fr, int fq) const {
        const int row0 = u.pm * BM + wr * 64 + fr, col0 = u.pn * BM + wc * 32 + 8 * fq;
#pragma unroll
        for (int ai = 0; ai < 2; ++ai)
#pragma unroll
            for (int m = 0; m < 4; ++m) { bf16_t* rowp = ob + (size_t)(row0 + ai * HALF + m * 16) * 2048 + col0;
#pragma unroll
                for (int bj = 0; bj < 2; ++bj) { const f32x4 v0 = acc[ai][bj][m][0], v1 = acc[ai][bj][m][1]; u32x4 w; w.x = cvt_pk_bf16(v0[0], v0[1]); w.y = cvt_pk_bf16(v0[2], v0[3]); w.z = cvt_pk_bf16(v1[0], v1[1]); w.w = cvt_pk_bf16(v1[2], v1[3]);
                    *(u32x4*)(rowp + bj * HALF) = w; } }
    }
};
__device__ __forceinline__ float cl448f(float v) { return fminf(fmaxf(v, -448.0f), 448.0f); }
__device__ __forceinline__ unsigned pk4_fp8(float a, float b, float c, float d) { int r; asm("" : "=v"(r));
    r = __builtin_amdgcn_cvt_pk_fp8_f32(a, b, r, false); r = __builtin_amdgcn_cvt_pk_fp8_f32(c, d, r, true); return (unsigned)r; }
struct EpiSwiglu {
    static constexpr bool PERM = true; static constexpr bool HAS_PREFETCH = false; static constexpr unsigned SCALE_W = 0x7c7c7c7cu, SCALE_A = 0x7c7c7c7cu  ; const float* b1; unsigned char* act;
    static constexpr bool ACC_BIAS = true;
    __device__ __forceinline__ void operator()(const f32x4 (&)[2][2][4][2], const Unit&, int, int, int, int) const {}
    __device__ __forceinline__ const float* bias_ptr(const Unit& u, int wc, int fq) const { return b1 + (size_t)u.e * 2048 + u.pn * 128 + wc * 32 + 8 * fq; }
    __device__ __forceinline__ void acc_init(f32x4 (&acc)[2][2][4][2], const Unit& u, int wc, int fq) const {
        const float* bg = bias_ptr(u, wc, fq);
#pragma unroll
        for (int n = 0; n < 2; ++n) { acc[0][0][0][n] = *(const f32x4*)(bg + 4 * n); acc[0][1][0][n] = *(const f32x4*)(bg + 1024 + 4 * n); }
#pragma unroll
        for (int a = 0; a < 2; ++a)
#pragma unroll
            for (int m = 0; m < 4; ++m)
#pragma unroll
                for (int n = 0; n < 2; ++n) { if (a + m) { acc[a][0][m][n] = acc[0][0][0][n]; acc[a][1][m][n] = acc[0][1][0][n]; } asm volatile("" : "+v"(acc[a][0][m][n]), "+v"(acc[a][1][m][n])); }
    }
    __device__ __forceinline__ void run_acc(f32x4 (&acc)[2][2][4][2], const Unit& u, const Unit& nx, bool has_next, int wr, int wc, int fr, int fq) const {
        float c7; asm volatile("v_mov_b32 %0, 0x40e00000" : "=v"(c7));
#pragma unroll
        for (int ai = 0; ai < 2; ++ai)
#pragma unroll
            for (int mp = 0; mp < 4; mp += 2) { u32x2 w[2];
#pragma unroll
                for (int q = 0; q < 2; ++q) { const int m = mp + q; float a[8];
#pragma unroll
                    for (int n = 0; n < 2; ++n) { const f32x4 gl = acc[ai][0][m][n], li = acc[ai][1][m][n];
#pragma unroll
                        for (int j = 0; j < 4; j += 2) {
                            float g0_, g1_; asm("v_min_f32 %0, %1, %2" : "=v"(g0_) : "v"(gl[j]), "v"(c7)); asm("v_min_f32 %0, %1, %2" : "=v"(g1_) : "v"(gl[j + 1]), "v"(c7));
                            const f32x2 g2 = {g0_, g1_}, l2 = {__builtin_amdgcn_fmed3f(li[j], -c7, c7), __builtin_amdgcn_fmed3f(li[j + 1], -c7, c7)};
                            const f32x2 t2 = g2 * (-1.702f * LOG2E); const f32x2 e2 = {__builtin_amdgcn_exp2f(t2[0]), __builtin_amdgcn_exp2f(t2[1])}; const f32x2 d2 = e2 + 1.0f;
                            const f32x2 r2 = {__builtin_amdgcn_rcpf(d2[0]), __builtin_amdgcn_rcpf(d2[1])}; const f32x2 o2 = (g2 * r2) * (l2 * 8.0f + 8.0f);
                            a[4 * n + j] = o2[0]; a[4 * n + j + 1] = o2[1]; } }
                    w[q].x = pk4_fp8(a[0], a[1], a[2], a[3]); w[q].y = pk4_fp8(a[4], a[5], a[6], a[7]); }
                const auto sx = __builtin_amdgcn_permlane16_swap(w[0].x, w[1].x, false, false), sy = __builtin_amdgcn_permlane16_swap(w[0].y, w[1].y, false, false);
                const unsigned row = (unsigned)(u.pm * BM + ai * HALF + wr * 64 + (mp + (fq & 1)) * 16 + fr);
                *(u32x4*)(act + (row * (unsigned)DM + (unsigned)(u.pn * 128 + wc * 32 + 16 * (fq >> 1)))) = (u32x4){sx[0], sy[0], sx[1], sy[1]};
                if (has_next && ai == 0 && mp == 0) { const float* bg = bias_ptr(nx, wc, fq);
#pragma unroll
                    for (int n = 0; n < 2; ++n) { acc[0][0][0][n] = *(const f32x4*)(bg + 4 * n); acc[0][1][0][n] = *(const f32x4*)(bg + 1024 + 4 * n); } } }
        if (has_next) {
#pragma unroll
            for (int a = 0; a < 2; ++a)
#pragma unroll
                for (int m = 0; m < 4; ++m)
#pragma unroll
                    for (int n = 0; n < 2; ++n) if (a + m) { acc[a][0][m][n] = acc[0][0][0][n]; acc[a][1][m][n] = acc[0][1][0][n]; } }
    }
    __device__ __forceinline__ void run(const f32x4 (&)[2][2][4][2], const Unit&, int, int, int, int, const LAS unsigned char*) const {}
    __device__ __forceinline__ const char* tk_base(const Unit&) const { return nullptr; }
    __device__ __forceinline__ const char* gate_base(const Unit&) const { return nullptr; }
    __device__ __forceinline__ const char* bias_base(const Unit&) const { return nullptr; }
};
struct EpiMoe2 {
    static constexpr bool PERM = true; static constexpr bool HAS_PREFETCH = true; static constexpr unsigned SCALE_W = 0x7c7c7c7cu, SCALE_A = 0x7c7c7c7cu  ;
    const float* b2; const int* extok; const float* exgate; unsigned char* ob; unsigned char* ys3;
    __device__ __forceinline__ const char* tk_base(const Unit& u) const { return (const char*)(extok + (size_t)u.e * 65536 + u.pos0); }
    __device__ __forceinline__ const char* gate_base(const Unit& u) const { return (const char*)(exgate + (size_t)u.e * 65536 + u.pos0); }
    __device__ __forceinline__ const char* bias_base(const Unit& u) const { return (const char*)(b2 + (size_t)u.e * DM + u.pn * BM); }
    __device__ __forceinline__ void operator()(const f32x4 (&)[2][2][4][2], const Unit&, int, int, int, int) const {}
    __device__ __forceinline__ void run(const f32x4 (&acc)[2][2][4][2], const Unit& u, int wr, int wc, int fr, int fq, const LAS unsigned char* ep) const {
        const int col = u.pn * BM + wc * 64 + 16 * fq; const LAS int* ltk = (const LAS int*)ep; const LAS float* lgt = (const LAS float*)(ep + 1024); const LAS float* lb = (const LAS float*)(ep + 2048) + wc * 64 + 16 * fq;
        f32x4 bv[2][2];
#pragma unroll
        for (int bj = 0; bj < 2; ++bj)
#pragma unroll
            for (int n = 0; n < 2; ++n) bv[bj][n] = *(const LAS f32x4*)(lb + 8 * bj + 4 * n);
#pragma unroll
        for (int ai = 0; ai < 2; ++ai)
#pragma unroll
            for (int m = 0; m < 4; ++m) { const int r = ai * HALF + wr * 64 + m * 16 + fr; const int tk = ltk[r]; const float gate = lgt[r];
                if (u.pos0 + r < u.cnt) { const int tok = tk >> 2, k = tk & 3;
                    const float g64 = gate * 64.0f; u32x4 w;
#pragma unroll
                    for (int bj = 0; bj < 2; ++bj) { const f32x4 v0 = (acc[ai][bj][m][0] + bv[bj][0]) * g64, v1 = (acc[ai][bj][m][1] + bv[bj][1]) * g64;
                        w[2 * bj] = pk4_fp8(cl448f(v0[0]), cl448f(v0[1]), cl448f(v0[2]), cl448f(v0[3])); w[2 * bj + 1] = pk4_fp8(cl448f(v1[0]), cl448f(v1[1]), cl448f(v1[2]), cl448f(v1[3])); }
                    if (k == 0) { const unsigned off = (unsigned)tok * 4096u + 2048u + (unsigned)col; *(u32x4*)(ob + off) = w; }
                    else { const unsigned off = ((unsigned)tok * 3u + (unsigned)(k - 1)) * (unsigned)DM + (unsigned)col; *(u32x4*)(ys3 + off) = w; } } }
    }
};
template <bool PERM_> struct EpiNull { static constexpr bool PERM = PERM_; static constexpr bool HAS_PREFETCH = false; static constexpr unsigned SCALE_W = 0x7f7f7f7fu, SCALE_A = 0x7f7f7f7fu;
    __device__ __forceinline__ void operator()(const f32x4 (&acc)[2][2][4][2], const Unit&, int, int, int, int) const {
#pragma unroll
        for (int a = 0; a < 2; ++a)
#pragma unroll
            for (int b = 0; b < 2; ++b)
#pragma unroll
                for (int m = 0; m < 4; ++m)
#pragma unroll
                    for (int n = 0; n < 2; ++n) asm volatile("" :: "v"(acc[a][b][m][n])); } };
}

#define RLX_AGENT __ATOMIC_RELAXED, __HIP_MEMORY_SCOPE_AGENT
#define LDS_WAIT() asm volatile("s_waitcnt lgkmcnt(0)" ::: "memory")
#define VM_WAIT() asm volatile("s_waitcnt vmcnt(0)" ::: "memory")
#define XB_TMO      128
#define XB_XCNT(j)  (256  + 64 * (j))
#define XB_XSUB(j)  (1280 + 64 * (j))
#define XB_XGEN(j)  (2304 + 64 * (j))
#define XB_TOP      3328
#define XB_TOPGEN   3392
#define XCD_BAR_WORDS 3456
#define XB_SPIN_CAP (1u << 18)

__device__ __forceinline__ unsigned xb_ld(unsigned* p)              { return __hip_atomic_load(p, __ATOMIC_RELAXED, __HIP_MEMORY_SCOPE_AGENT); }
__device__ __forceinline__ unsigned xb_add(unsigned* p, unsigned v) { return __hip_atomic_fetch_add(p, v, __ATOMIC_RELAXED, __HIP_MEMORY_SCOPE_AGENT); }
__device__ __forceinline__ unsigned xb_xcc_id() { return (unsigned)__builtin_amdgcn_s_getreg((3 << 11) | 20) & 0xFu; }
#define XB_SPIN(cond, bar) do { unsigned _sp = 0; while (cond) { __builtin_amdgcn_s_sleep(1); \
    if ((++_sp & 255u) == 0u) { if (xb_ld(&(bar)[XB_TMO])) break; if (_sp > XB_SPIN_CAP) { atomicAdd(&(bar)[XB_TMO], 1u); break; } } } } while (0)

struct XcdBarrier {
    unsigned* bar; unsigned x; int wave;
    volatile LAS unsigned* st;
};

__device__ __forceinline__ XcdBarrier xcd_barrier_post(unsigned* bar, volatile LAS unsigned* st, int wave) {
    XcdBarrier b; b.bar = bar; b.x = xb_xcc_id(); b.st = st; b.wave = wave;
    if (wave == 0 && fresh_lane() == 0) (void)xb_add(&bar[XB_XCNT(b.x)], 1u);
    return b;
}
__device__ __forceinline__ void xcd_barrier_complete(unsigned* bar, unsigned x, unsigned& nloc, unsigned& nx) {
    const unsigned G = gridDim.x * gridDim.y * gridDim.z;
    unsigned sum, cnt, mine, sp = 0u;
    for (;;) {
        sum = 0u; cnt = 0u; mine = 0u;
#pragma unroll
        for (unsigned j = 0; j < 16; ++j) { const unsigned c = xb_ld(&bar[XB_XCNT(j)]); sum += c; cnt += (c > 0u) ? 1u : 0u; mine = (j == x) ? c : mine; }
        if (sum == G) break;
        __builtin_amdgcn_s_sleep(1);
        if ((++sp & 255u) == 0u) { if (xb_ld(&bar[XB_TMO])) break; if (sp > XB_SPIN_CAP) { atomicAdd(&bar[XB_TMO], 1u); break; } }
    }
    nloc = mine > 0u ? mine : 1u; nx = cnt > 0u ? cnt : 1u;
}

__device__ __forceinline__ void xcd_barrier(const XcdBarrier& b) {
    asm volatile("s_waitcnt vmcnt(0)" ::: "memory");
    __syncthreads();
    if (b.wave == 0 && fresh_lane() == 0) {
        unsigned* bar = b.bar;
        __builtin_amdgcn_s_waitcnt(0);
        unsigned nloc = b.st[0], nx = b.st[1];
        if (nloc == 0u) { xcd_barrier_complete(bar, b.x, nloc, nx); b.st[0] = nloc; b.st[1] = nx; }
        const unsigned old = xb_add(&bar[XB_XSUB(b.x)], 1u);
        const unsigned gen = old / nloc;
        if (old + 1u == (gen + 1u) * nloc) {
            __builtin_amdgcn_fence(__ATOMIC_RELEASE, "agent");
            asm volatile("s_waitcnt vmcnt(0)" ::: "memory");
            const unsigned og = xb_add(&bar[XB_TOP], 1u);
            const unsigned tg = og / nx;
            if (og + 1u == (tg + 1u) * nx) xb_add(&bar[XB_TOPGEN], 1u);
            else XB_SPIN(xb_ld(&bar[XB_TOPGEN]) == tg, bar);
            __builtin_amdgcn_fence(__ATOMIC_ACQUIRE, "agent");
            xb_add(&bar[XB_XGEN(b.x)], 1u);
            asm volatile("s_waitcnt vmcnt(0)" ::: "memory");
        } else {
            XB_SPIN(xb_ld(&bar[XB_XGEN(b.x)]) == gen, bar);
            __builtin_amdgcn_fence(__ATOMIC_ACQUIRE, "agent");
            asm volatile("s_waitcnt vmcnt(0)" ::: "memory");
        }
    }
    __syncthreads();
}


__device__ __forceinline__ unsigned pk2(float lo, float hi) { return (unsigned)f2bf(lo) | ((unsigned)f2bf(hi) << 16); }
__device__ __forceinline__ int rmap_win(int c) { const int hc = c >> 6, d = c & 63, pn = hc >> 2, wc = hc & 3, bj = d >> 5, dd = d & 31; const int i = (hc >= 12 && hc < 28) ? bslot(dd) : dd; return 256 * pn + 128 * bj + 32 * wc + i; }
__device__ __forceinline__ int rmap_w1(int c) { const int bj = c >> 10, cc = c & 1023; return 256 * (cc >> 7) + 128 * bj + (cc & 127); }
__device__ __forceinline__ int rmap_w2(int c) { const int cc = c & 255; return (c & ~255) + 128 * ((cc >> 3) & 1) + 32 * (cc >> 6) + 8 * ((cc >> 4) & 3) + (cc & 7); }
template <int MAP> __device__ __forceinline__ void p0_transpose_item(const float* W, int N, bf16_t* WT, LAS float* scr, int item, int lane) {
    const int nblk = N / 32, kb = item / nblk, nb = item % nblk, k0 = 64 * kb, n0 = 32 * nb;
#pragma unroll 8
    for (int i = 0; i < 32; ++i) { const int kk = 2 * i + (lane >> 5); scr[kk * 33 + (lane & 31)] = W[(size_t)(k0 + kk) * N + n0 + (lane & 31)]; }
    LDS_WAIT(); asm volatile("" ::: "memory");
    const int c = lane & 7;
#pragma unroll
    for (int j = 0; j < 4; ++j) { const int n = (lane >> 3) + 8 * j; const LAS float* s = scr + (8 * c) * 33 + n;
        u32x4 o; o.x = pk2(s[0 * 33], s[1 * 33]); o.y = pk2(s[2 * 33], s[3 * 33]); o.z = pk2(s[4 * 33], s[5 * 33]); o.w = pk2(s[6 * 33], s[7 * 33]);
        const int src = n0 + n; const int row = MAP == 1 ? rmap_win(src) : MAP == 2 ? rmap_w1(src) : src;
        *(u32x4*)(WT + (size_t)row * DM + k0 + 8 * c) = o; }
    LDS_WAIT(); asm volatile("" ::: "memory");
}
__device__ __forceinline__ float cl448(float v) { return fminf(fmaxf(v, -448.0f), 448.0f); }
struct F8Item { const float* W; unsigned char* WT; int N, k0, n0, map; };
__device__ __forceinline__ F8Item f8_item(const P& p, int r) {
    constexpr int I_W1 = 8 * 64, I_W2 = 8 * 32; F8Item it;
    if (r < NE * I_W1) { const int e = r / I_W1, q = r % I_W1; it.W = p.w1 + (size_t)e * DM * 2048; it.WT = p.ws + WS_W1T + (size_t)e * 2048 * DM; it.N = 2048; it.k0 = 128 * (q / 64); it.n0 = 32 * (q % 64); it.map = 1; }
    else { r -= NE * I_W1; const int e = r / I_W2, q = r % I_W2; it.W = p.w2 + (size_t)e * DM * DM; it.WT = p.ws + WS_W2T + (size_t)e * DM * DM; it.N = DM; it.k0 = 128 * (q / 32); it.n0 = 32 * (q % 32); it.map = 0; }
    return it;
}
__device__ __forceinline__ void f8_load(const F8Item& it, f32x4 (&v)[16], int lane) {
#pragma unroll
    for (int i = 0; i < 16; ++i) v[i] = *(const f32x4*)(it.W + (size_t)(it.k0 + 32 * (i >> 2) + 4 * (lane >> 3) + (i & 3)) * it.N + it.n0 + 4 * (lane & 7));
}
__device__ __forceinline__ void f8_pack(const f32x4 (&v)[16], LAS float* scr, int lane) {
    LAS unsigned* su = (LAS unsigned*)scr; const int nq = lane & 7, kg = lane >> 3;
#pragma unroll
    for (int i2 = 0; i2 < 4; ++i2)
#pragma unroll
        for (int x = 0; x < 4; ++x) { const int r = 4 * nq + x, chunk = 2 * i2 + (kg >> 2);
            su[r * 32 + ((chunk ^ (r & 7)) << 2) + (kg & 3)] = pg8::pk4_fp8(cl448(8.0f * v[4 * i2][x]), cl448(8.0f * v[4 * i2 + 1][x]), cl448(8.0f * v[4 * i2 + 2][x]), cl448(8.0f * v[4 * i2 + 3][x])); }
    LDS_WAIT(); asm volatile("" ::: "memory");
}
__device__ __forceinline__ void f8_store(const F8Item& it, LAS float* scr, int lane) {
    const LAS unsigned* su = (const LAS unsigned*)scr; const int n = lane >> 1, half = lane & 1;
    u32x4 o[4];
#pragma unroll
    for (int q = 0; q < 4; ++q) o[q] = *(const LAS u32x4*)(su + n * 32 + (((4 * half + q) ^ (n & 7)) << 2));
    const int src = it.n0 + n; const int row = it.map ? rmap_w1(src) : rmap_w2(src); unsigned char* dst = it.WT + (size_t)row * DM + it.k0 + 64 * half;
#pragma unroll
    for (int q = 0; q < 4; ++q) *(u32x4*)(dst + 16 * q) = o[q];
    LDS_WAIT(); asm volatile("" ::: "memory");
}
__device__ __forceinline__ void f8_share(const P& p, LAS unsigned char* ring, int G, int vcu, int wave) {
    const int lane = fresh_lane(); LAS float* scr = (LAS float*)(ring + wave * 16384);
    const int gw = vcu * NWAVES + wave, NGW = G * NWAVES; constexpr int NF8 = NE * (8 * 64 + 8 * 32);
    f32x4 va[16], vb[16]; int it = gw;
    F8Item ia = f8_item(p, it < NF8 ? it : 0), ib = ia;
    if (it < NF8) f8_load(ia, va, lane);
    if (it + NGW < NF8) { ib = f8_item(p, it + NGW); f8_load(ib, vb, lane); }
    while (it < NF8) {
        { const F8Item cur = ia; f8_pack(va, scr, lane); if (it + 2 * NGW < NF8) { ia = f8_item(p, it + 2 * NGW); f8_load(ia, va, lane); } f8_store(cur, scr, lane); }
        if (it + NGW >= NF8) break;
        { const F8Item cur = ib; f8_pack(vb, scr, lane); if (it + 3 * NGW < NF8) { ib = f8_item(p, it + 3 * NGW); f8_load(ib, vb, lane); } f8_store(cur, scr, lane); }
        it += 2 * NGW;
    }
}


namespace att {
typedef float f32x16 __attribute__((ext_vector_type(16)));
typedef short s16x4 __attribute__((ext_vector_type(4)));
typedef short v4i16_t __attribute__((ext_vector_type(4)));
constexpr int SLOTB = 16384, NSLOT = 3, STG_OFF = NSLOT * SLOTB, STG_W = 8704, WS_OFF = 8 * STG_W + STG_OFF;
constexpr int GDH_OFF = WS_OFF + 8 * 256, ATT_LDS = GDH_OFF + 256;
static_assert(ATT_LDS <= RING_BYTES, "attention LDS");
__device__ __forceinline__ int crow(int r, int hi) { return (r & 3) + 8 * (r >> 2) + 4 * hi; }
__device__ __forceinline__ unsigned cvtpk(float lo, float hi) { unsigned r; asm volatile("v_cvt_pk_bf16_f32 %0, %1, %2" : "=v"(r) : "v"(lo), "v"(hi)); return r; }
__device__ __forceinline__ s16x4 vtr(const LAS unsigned char* p) { return __builtin_bit_cast(s16x4, __builtin_amdgcn_ds_read_tr16_b64_v4i16((LAS v4i16_t*)p)); }
#define ATT_WAITV(n) asm volatile("s_waitcnt vmcnt(" #n ")" ::: "memory")
#define ATT_BAR() do { asm volatile("s_waitcnt lgkmcnt(0)" ::: "memory"); __builtin_amdgcn_s_barrier(); asm volatile("" ::: "memory"); } while (0)

template <int D0, int ND, bool HALF1> __device__ __forceinline__ void qk(f32x16& p0, f32x16& p1, const LAS unsigned char* kb, const bf16x8 (&qr)[4]) {
    const f32x16 z = {0.f, 0.f, 0.f, 0.f, 0.f, 0.f, 0.f, 0.f, 0.f, 0.f, 0.f, 0.f, 0.f, 0.f, 0.f, 0.f};
#pragma unroll
    for (int d = 0; d < ND; ++d) {
        const bf16x8 k0 = *(const LAS bf16x8*)(kb + (D0 + d) * 2048);
        p0 = __builtin_amdgcn_mfma_f32_32x32x16_bf16(k0, qr[D0 + d], d == 0 ? z : p0, 0, 0, 0);
        if (HALF1) { const bf16x8 k1 = *(const LAS bf16x8*)(kb + (D0 + d) * 2048 + 512); p1 = __builtin_amdgcn_mfma_f32_32x32x16_bf16(k1, qr[D0 + d], d == 0 ? z : p1, 0, 0, 0); }
    }
}
__device__ __forceinline__ void softpack(f32x16& s, float& l, u32x4& w0, u32x4& w1) {
#pragma unroll
    for (int r = 0; r < 16; ++r) s[r] = __builtin_amdgcn_exp2f(s[r]);
    float a = (s[0] + s[1]) + (s[2] + s[3]), b = (s[4] + s[5]) + (s[6] + s[7]), c = (s[8] + s[9]) + (s[10] + s[11]), d = (s[12] + s[13]) + (s[14] + s[15]);
    l += (a + b) + (c + d);
    w0.x = cvtpk(s[0], s[1]); w0.y = cvtpk(s[2], s[3]); w0.z = cvtpk(s[4], s[5]); w0.w = cvtpk(s[6], s[7]);
    w1.x = cvtpk(s[8], s[9]); w1.y = cvtpk(s[10], s[11]); w1.z = cvtpk(s[12], s[13]); w1.w = cvtpk(s[14], s[15]);
}
#define ATT_TR(dst, addr, OFF) asm volatile("ds_read_b64_tr_b16 %0, %1 offset:%c2" : "=&v"(dst) : "v"(addr), "i"(OFF) : "memory")
#define ATT_LGKM0() do { asm volatile("s_waitcnt lgkmcnt(0)" ::: "memory"); __builtin_amdgcn_sched_barrier(0); } while (0)
#define ATT_VF(lo, hi) (bf16x8){lo[0], lo[1], lo[2], lo[3], hi[0], hi[1], hi[2], hi[3]}

struct Src { const bf16_t* q; const bf16_t* k; const bf16_t* v; const bf16_t* km; const bf16_t* vm; int t0, ntr; };

template <bool DIFF> __device__ __forceinline__ void unit(const P& p, LAS unsigned char* lds, const Src& S, int qa  , float lam, float sinkp, bf16_t* orow  , const int wid,
                                                     bf16x8 (&qr)[4], const bool pre  , const bool pn  , const Src& Sn) {
    const int lane = fresh_lane(), tid = wid * 64 + lane, r32 = lane & 31, hi = lane >> 5;
    const int NT = S.ntr + 1;
#define ATT_DMA_S(SS, j, slot) do { const bf16_t* ks_ = (j) < SS.ntr ? SS.k + (size_t)(SS.t0 + (j)) * TILE_EL : SS.km; const bf16_t* vs_ = (j) < SS.ntr ? SS.v + (size_t)(SS.t0 + (j)) * TILE_EL : SS.vm; \
        __builtin_amdgcn_global_load_lds((const unsigned*)(ks_ + tid * 8), (LAS unsigned*)(lds + (slot) + wid * 1024), 16, 0, 0); \
        __builtin_amdgcn_global_load_lds((const unsigned*)(vs_ + tid * 8), (LAS unsigned*)(lds + (slot) + 8192 + wid * 1024), 16, 0, 0); } while (0)
#define ATT_DMA(j, slot) ATT_DMA_S(S, j, slot)
    if (!pre) {
#pragma unroll
        for (int d0 = 0; d0 < 4; ++d0) qr[d0] = *(const bf16x8*)(S.q + (size_t)r32 * 64 + d0 * 16 + hi * 8);
        ATT_DMA(0, 0); ATT_DMA(1, SLOTB); }
    f32x16 o1[2], o2[2];
#pragma unroll
    for (int d = 0; d < 2; ++d)
#pragma unroll
        for (int r = 0; r < 16; ++r) { o1[d][r] = 0.f; o2[d][r] = 0.f; }
    float l1 = 0.f, l2 = 0.f;
    int sl_cur = 0, sl_n1 = SLOTB, sl_n2 = 2 * SLOTB;
    const int koff = hi * 1024 + r32 * 16;
    const int voff = 8192 + ((lane >> 4) & 1) * 32 + (lane & 3) * 8 + (4 * hi + ((lane & 15) >> 2)) * 64;
    for (int j = 0; j < NT; ++j) {
        if (j + 1 < NT) ATT_WAITV(2); else ATT_WAITV(0);
        ATT_BAR();
        if (j + 2 < NT) ATT_DMA(j + 2, sl_n2);
        const LAS unsigned char* kb = lds + sl_cur + koff; const unsigned vpa = (unsigned)(__SIZE_TYPE__)(lds + sl_cur + voff);
        if (j < S.ntr) {
            bool act = true, full = true;
            if (!DIFF) { const int kt = 64 * (S.t0 + j); act = (kt + 63 >= qa - 128) && (kt <= qa + 31 + 128); full = (qa + 31 - kt <= 128) && (kt + 63 - qa <= 128); }
            if (act) {
                f32x16 sa0, sa1, sb0, sb1; u32x4 wa[4], wb[4];
                if (DIFF) { qk<0, 2, true>(sa0, sa1, kb, qr); qk<2, 2, true>(sb0, sb1, kb, qr); }
                else { qk<0, 4, true>(sa0, sa1, kb, qr);
                    if (!full) { const int q = qa + r32, kt = 64 * (S.t0 + j) + 4 * hi;
#pragma unroll
                        for (int r = 0; r < 16; ++r) { const int kv = kt + (r & 3) + 8 * (r >> 2); const int d0 = q - kv, d1 = q - kv - 32;
                            if (d0 > 128 || d0 < -128) sa0[r] = -INFINITY; if (d1 > 128 || d1 < -128) sa1[r] = -INFINITY; } } }
                softpack(sa0, l1, wa[0], wa[1]); softpack(sa1, l1, wa[2], wa[3]);
                if (DIFF) { softpack(sb0, l2, wb[0], wb[1]); softpack(sb1, l2, wb[2], wb[3]); }
#pragma unroll
                for (int d0 = 0; d0 < 2; ++d0) {
                    s16x4 vl[4], vh[4];
                    ATT_TR(vl[0], vpa, d0 * 4096); ATT_TR(vh[0], vpa, d0 * 4096 + 512); ATT_TR(vl[1], vpa, d0 * 4096 + 1024); ATT_TR(vh[1], vpa, d0 * 4096 + 1024 + 512);
                    ATT_TR(vl[2], vpa, d0 * 4096 + 2048); ATT_TR(vh[2], vpa, d0 * 4096 + 2048 + 512); ATT_TR(vl[3], vpa, d0 * 4096 + 3072); ATT_TR(vh[3], vpa, d0 * 4096 + 3072 + 512);
                    ATT_LGKM0();
#pragma unroll
                    for (int ks = 0; ks < 4; ++ks) { const bf16x8 vf = ATT_VF(vl[ks], vh[ks]); o1[d0] = __builtin_amdgcn_mfma_f32_32x32x16_bf16(__builtin_bit_cast(bf16x8, wa[ks]), vf, o1[d0], 0, 0, 0);
                        if (DIFF) o2[d0] = __builtin_amdgcn_mfma_f32_32x32x16_bf16(__builtin_bit_cast(bf16x8, wb[ks]), vf, o2[d0], 0, 0, 0); }
                }
            }
        } else {
            f32x16 sa0, sa1, sb0, sb1; u32x4 wa0, wb0;
            if (DIFF) { qk<0, 2, false>(sa0, sa1, kb, qr); qk<2, 2, false>(sb0, sb1, kb, qr); } else qk<0, 4, false>(sa0, sa1, kb, qr);
            { float e[8];
#pragma unroll
              for (int r = 0; r < 8; ++r) { e[r] = __builtin_amdgcn_exp2f(sa0[r]); }
              l1 += ((e[0] + e[1]) + (e[2] + e[3])) + ((e[4] + e[5]) + (e[6] + e[7]));
              wa0.x = cvtpk(e[0], e[1]); wa0.y = cvtpk(e[2], e[3]); wa0.z = cvtpk(e[4], e[5]); wa0.w = cvtpk(e[6], e[7]); }
            if (DIFF) { float e[8];
#pragma unroll
              for (int r = 0; r < 8; ++r) { e[r] = __builtin_amdgcn_exp2f(sb0[r]); }
              l2 += ((e[0] + e[1]) + (e[2] + e[3])) + ((e[4] + e[5]) + (e[6] + e[7]));
              wb0.x = cvtpk(e[0], e[1]); wb0.y = cvtpk(e[2], e[3]); wb0.z = cvtpk(e[4], e[5]); wb0.w = cvtpk(e[6], e[7]); }
#pragma unroll
            for (int d0 = 0; d0 < 2; ++d0) { s16x4 ml, mh; ATT_TR(ml, vpa, d0 * 4096); ATT_TR(mh, vpa, d0 * 4096 + 512); ATT_LGKM0(); const bf16x8 vf = ATT_VF(ml, mh);
                o1[d0] = __builtin_amdgcn_mfma_f32_32x32x16_bf16(__builtin_bit_cast(bf16x8, wa0), vf, o1[d0], 0, 0, 0);
                if (DIFF) o2[d0] = __builtin_amdgcn_mfma_f32_32x32x16_bf16(__builtin_bit_cast(bf16x8, wb0), vf, o2[d0], 0, 0, 0); }
        }
        { const int t_ = sl_cur; sl_cur = sl_n1; sl_n1 = sl_n2; sl_n2 = t_; }
    }
    ATT_BAR();
    bf16x8 qn[4];
    if (pn) {
#pragma unroll
        for (int d0 = 0; d0 < 4; ++d0) qn[d0] = *(const bf16x8*)(Sn.q + (size_t)r32 * 64 + d0 * 16 + hi * 8);
        ATT_DMA_S(Sn, 0, 0); ATT_DMA_S(Sn, 1, SLOTB); }
    l1 += shx(l1, 32, lane); if (DIFF) l2 += shx(l2, 32, lane); else l1 += sinkp;
    LAS float* wsf = (LAS float*)(lds + WS_OFF + wid * 256);
    if (hi == 0) { wsf[r32] = 1.0f / l1; if (DIFF) wsf[32 + r32] = lam / l2; }
    asm volatile("s_waitcnt lgkmcnt(0)" ::: "memory");
    LAS float* stg = (LAS float*)(lds + STG_OFF + wid * STG_W);
#pragma unroll
    for (int r = 0; r < 16; ++r) { const int qrow = crow(r, hi); const float i1 = wsf[qrow]; const float i2 = DIFF ? wsf[32 + qrow] : 0.f;
#pragma unroll
        for (int d0 = 0; d0 < 2; ++d0) stg[qrow * 68 + d0 * 32 + r32] = DIFF ? o1[d0][r] * i1 - o2[d0][r] * i2 : o1[d0][r] * i1; }
    asm volatile("s_waitcnt lgkmcnt(0)" ::: "memory");
    { const int row = lane >> 1, hf = lane & 1; const LAS f32x4* src = (const LAS f32x4*)(stg + row * 68 + hf * 32); f32x4 v[8]; float ss = 0.f;
#pragma unroll
      for (int i = 0; i < 8; ++i) { v[i] = src[i]; ss += (v[i][0] * v[i][0] + v[i][1] * v[i][1]) + (v[i][2] * v[i][2] + v[i][3] * v[i][3]); }
      float sc = 1.0f;
      if (DIFF) { ss += shx(ss, 1, lane); sc = rsqrtf(ss * (1.0f / 64.0f) + 1e-5f) * 0.8f; }
      bf16_t* dst = orow + (size_t)row * DM + hf * 32;
#pragma unroll
      for (int i = 0; i < 4; ++i) { f32x4 a = v[2 * i] * sc, c = v[2 * i + 1] * sc;
          if (DIFF) { a = a * *(const f32x4*)(p.g_dh + hf * 32 + 8 * i); c = c * *(const f32x4*)(p.g_dh + hf * 32 + 8 * i + 4); }
          u32x4 w; w.x = cvtpk(a[0], a[1]); w.y = cvtpk(a[2], a[3]); w.z = cvtpk(c[0], c[1]); w.w = cvtpk(c[2], c[3]); *(u32x4*)(dst + 8 * i) = w; } }
    if (pn) {
#pragma unroll
        for (int d0 = 0; d0 < 4; ++d0) qr[d0] = qn[d0]; }
#undef ATT_DMA
#undef ATT_DMA_S
}


constexpr int D_NSLOT = 4;
#define ATT_PIN(x) asm volatile("" : "+v"(x))
#define ATT_SB() __builtin_amdgcn_sched_barrier(0)
__device__ __forceinline__ float fadd_s(float a, float b) { float r; asm volatile("v_add_f32_e32 %0, %1, %2" : "=v"(r) : "v"(a), "v"(b)); return r; }
#define ATT_SUM8(P, B) fadd_s(fadd_s(fadd_s(P[B], P[B + 1]), fadd_s(P[B + 2], P[B + 3])), fadd_s(fadd_s(P[B + 4], P[B + 5]), fadd_s(P[B + 6], P[B + 7])))
template <bool HAVE_PREV, bool HAVE_NEXT> __device__ __forceinline__ void dstep(f32x16& ca, f32x16& cb, f32x16& pa, f32x16& pb, const bf16x8 (&kf)[4], bf16x8 (&kn)[4], const LAS unsigned char* kbn, unsigned vpa,
                                                                const bf16x8 (&qr)[4], f32x16 (&o1)[2], f32x16 (&o2)[2], float& l1, float& l2) {
    const f32x16 z = {0.f, 0.f, 0.f, 0.f, 0.f, 0.f, 0.f, 0.f, 0.f, 0.f, 0.f, 0.f, 0.f, 0.f, 0.f, 0.f};
    s16x4 vl[2][2], vh[2][2]; u32x4 wa[2], wb[2];
    ca = __builtin_amdgcn_mfma_f32_32x32x16_bf16(kf[0], qr[0], z, 0, 0, 0);
    float a0, a1, a2, a3, a4, a5, a6, a7, b0, b1, b2, b3, b4, b5, b6, b7;
    if (HAVE_PREV) { a0 = fadd_s(pa[0], pa[1]); a1 = fadd_s(pa[2], pa[3]); a2 = fadd_s(pa[4], pa[5]); a3 = fadd_s(pa[6], pa[7]); a4 = fadd_s(pa[8], pa[9]); a5 = fadd_s(pa[10], pa[11]); a6 = fadd_s(pa[12], pa[13]); a7 = fadd_s(pa[14], pa[15]);
        wa[0].x = cvtpk(pa[0], pa[1]); wa[0].y = cvtpk(pa[2], pa[3]); wa[0].z = cvtpk(pa[4], pa[5]); wa[0].w = cvtpk(pa[6], pa[7]); }
    ATT_SB();
    ca = __builtin_amdgcn_mfma_f32_32x32x16_bf16(kf[1], qr[1], ca, 0, 0, 0);
    if (HAVE_PREV) {
        ATT_TR(vl[0][0], vpa, 0); ATT_TR(vh[0][0], vpa, 512); ATT_TR(vl[1][0], vpa, 4096); ATT_TR(vh[1][0], vpa, 4096 + 512);
        ATT_TR(vl[0][1], vpa, 1024); ATT_TR(vh[0][1], vpa, 1024 + 512); ATT_TR(vl[1][1], vpa, 4096 + 1024); ATT_TR(vh[1][1], vpa, 4096 + 1024 + 512);
        a0 = fadd_s(a0, a1); a2 = fadd_s(a2, a3); a4 = fadd_s(a4, a5); a6 = fadd_s(a6, a7);
        wa[1].x = cvtpk(pa[8], pa[9]); wa[1].y = cvtpk(pa[10], pa[11]); wa[1].z = cvtpk(pa[12], pa[13]); wa[1].w = cvtpk(pa[14], pa[15]);
        a0 = fadd_s(a0, a2); a4 = fadd_s(a4, a6); }
    ATT_SB();
    cb = __builtin_amdgcn_mfma_f32_32x32x16_bf16(kf[2], qr[2], z, 0, 0, 0);
    if (HAVE_PREV) { b0 = fadd_s(pb[0], pb[1]); b1 = fadd_s(pb[2], pb[3]); b2 = fadd_s(pb[4], pb[5]); b3 = fadd_s(pb[6], pb[7]); b4 = fadd_s(pb[8], pb[9]); b5 = fadd_s(pb[10], pb[11]); b6 = fadd_s(pb[12], pb[13]); b7 = fadd_s(pb[14], pb[15]);
        wb[0].x = cvtpk(pb[0], pb[1]); wb[0].y = cvtpk(pb[2], pb[3]); wb[0].z = cvtpk(pb[4], pb[5]); wb[0].w = cvtpk(pb[6], pb[7]);
        a0 = fadd_s(a0, a4); }
    ATT_SB();
    cb = __builtin_amdgcn_mfma_f32_32x32x16_bf16(kf[3], qr[3], cb, 0, 0, 0);
    if (HAVE_PREV) { b0 = fadd_s(b0, b1); b2 = fadd_s(b2, b3); b4 = fadd_s(b4, b5); b6 = fadd_s(b6, b7);
        wb[1].x = cvtpk(pb[8], pb[9]); wb[1].y = cvtpk(pb[10], pb[11]); wb[1].z = cvtpk(pb[12], pb[13]); wb[1].w = cvtpk(pb[14], pb[15]);
        b0 = fadd_s(b0, b2); b4 = fadd_s(b4, b6); l1 = fadd_s(l1, a0); b0 = fadd_s(b0, b4); }
    asm volatile("s_waitcnt lgkmcnt(0)" ::: "memory"); ATT_SB();
#if defined(PROBE_MFMA2)
    f32x16 dmy = z;
#define ATT_DUP(A, B) do { if (HAVE_PREV) { dmy = __builtin_amdgcn_mfma_f32_32x32x16_bf16(A, B, dmy, 0, 0, 0); } } while (0)
#else
#define ATT_DUP(A, B) do { } while (0)
#endif
    if (HAVE_PREV) l2 = fadd_s(l2, b0);
#if defined(PROBE_EXP2)
#define ATT_EX4(X, B) do { float d0_ = __builtin_amdgcn_exp2f(X[B] + 0.0f), d1_ = __builtin_amdgcn_exp2f(X[B + 1] + 0.0f), d2_ = __builtin_amdgcn_exp2f(X[B + 2] + 0.0f), d3_ = __builtin_amdgcn_exp2f(X[B + 3] + 0.0f); asm volatile("" :: "v"(d0_), "v"(d1_), "v"(d2_), "v"(d3_)); \
    X[B] = __builtin_amdgcn_exp2f(X[B]); X[B + 1] = __builtin_amdgcn_exp2f(X[B + 1]); X[B + 2] = __builtin_amdgcn_exp2f(X[B + 2]); X[B + 3] = __builtin_amdgcn_exp2f(X[B + 3]); ATT_PIN(X); } while (0)
#else
#define ATT_EX4(X, B) do { X[B] = __builtin_amdgcn_exp2f(X[B]); X[B + 1] = __builtin_amdgcn_exp2f(X[B + 1]); X[B + 2] = __builtin_amdgcn_exp2f(X[B + 2]); X[B + 3] = __builtin_amdgcn_exp2f(X[B + 3]); ATT_PIN(X); } while (0)
#endif
    if (HAVE_NEXT) { kn[0] = *(const LAS bf16x8*)(kbn); kn[1] = *(const LAS bf16x8*)(kbn + 2048); kn[2] = *(const LAS bf16x8*)(kbn + 4096); kn[3] = *(const LAS bf16x8*)(kbn + 6144); }
    if (HAVE_PREV) o1[0] = __builtin_amdgcn_mfma_f32_32x32x16_bf16(__builtin_bit_cast(bf16x8, wa[0]), ATT_VF(vl[0][0], vh[0][0]), o1[0], 0, 0, 0);
    ATT_DUP(__builtin_bit_cast(bf16x8, wa[0]), ATT_VF(vl[0][0], vh[0][0]));
    ATT_EX4(ca, 0); ATT_SB();
    if (HAVE_PREV) o1[1] = __builtin_amdgcn_mfma_f32_32x32x16_bf16(__builtin_bit_cast(bf16x8, wa[0]), ATT_VF(vl[1][0], vh[1][0]), o1[1], 0, 0, 0);
    ATT_DUP(__builtin_bit_cast(bf16x8, wa[0]), ATT_VF(vl[1][0], vh[1][0]));
    ATT_EX4(ca, 4); ATT_SB();
    if (HAVE_PREV) o2[0] = __builtin_amdgcn_mfma_f32_32x32x16_bf16(__builtin_bit_cast(bf16x8, wb[0]), ATT_VF(vl[0][0], vh[0][0]), o2[0], 0, 0, 0);
    ATT_DUP(__builtin_bit_cast(bf16x8, wb[0]), ATT_VF(vl[0][0], vh[0][0]));
    ATT_EX4(ca, 8); ATT_SB();
    if (HAVE_PREV) o2[1] = __builtin_amdgcn_mfma_f32_32x32x16_bf16(__builtin_bit_cast(bf16x8, wb[0]), ATT_VF(vl[1][0], vh[1][0]), o2[1], 0, 0, 0);
    ATT_DUP(__builtin_bit_cast(bf16x8, wb[0]), ATT_VF(vl[1][0], vh[1][0]));
    ATT_EX4(ca, 12); ATT_SB();
    if (HAVE_PREV) o1[0] = __builtin_amdgcn_mfma_f32_32x32x16_bf16(__builtin_bit_cast(bf16x8, wa[1]), ATT_VF(vl[0][1], vh[0][1]), o1[0], 0, 0, 0);
    ATT_DUP(__builtin_bit_cast(bf16x8, wa[1]), ATT_VF(vl[0][1], vh[0][1]));
    ATT_EX4(cb, 0); ATT_SB();
    if (HAVE_PREV) o1[1] = __builtin_amdgcn_mfma_f32_32x32x16_bf16(__builtin_bit_cast(bf16x8, wa[1]), ATT_VF(vl[1][1], vh[1][1]), o1[1], 0, 0, 0);
    ATT_DUP(__builtin_bit_cast(bf16x8, wa[1]), ATT_VF(vl[1][1], vh[1][1]));
    ATT_EX4(cb, 4); ATT_SB();
    if (HAVE_PREV) o2[0] = __builtin_amdgcn_mfma_f32_32x32x16_bf16(__builtin_bit_cast(bf16x8, wb[1]), ATT_VF(vl[0][1], vh[0][1]), o2[0], 0, 0, 0);
    ATT_DUP(__builtin_bit_cast(bf16x8, wb[1]), ATT_VF(vl[0][1], vh[0][1]));
    ATT_EX4(cb, 8); ATT_SB();
    if (HAVE_PREV) o2[1] = __builtin_amdgcn_mfma_f32_32x32x16_bf16(__builtin_bit_cast(bf16x8, wb[1]), ATT_VF(vl[1][1], vh[1][1]), o2[1], 0, 0, 0);
    ATT_DUP(__builtin_bit_cast(bf16x8, wb[1]), ATT_VF(vl[1][1], vh[1][1]));
    ATT_EX4(cb, 12); ATT_SB();
#if defined(PROBE_MFMA2)
    asm volatile("" :: "v"(dmy));
#endif
#undef ATT_DUP
#undef ATT_EX4
}
__device__ __forceinline__ void unit_diff(const P& p, LAS unsigned char* lds, const Src& S, float lam, bf16_t* orow, const int wid,
                                          bf16x8 (&qr)[4], const bool pre  , const bool pn  , const Src& Sn) {
    const int lane = fresh_lane(), tid = wid * 64 + lane, r32 = lane & 31, hi = lane >> 5;
    constexpr int NTR = 64;
#define ATT_DMA_S(SS, j, slot) do { const bf16_t* ks_ = (j) < NTR ? SS.k + (size_t)(j) * TILE_EL : SS.km; const bf16_t* vs_ = (j) < NTR ? SS.v + (size_t)(j) * TILE_EL : SS.vm; \
        __builtin_amdgcn_global_load_lds((const unsigned*)(ks_ + tid * 8), (LAS unsigned*)(lds + (slot) + wid * 1024), 16, 0, 0); \
        __builtin_amdgcn_global_load_lds((const unsigned*)(vs_ + tid * 8), (LAS unsigned*)(lds + (slot) + 8192 + wid * 1024), 16, 0, 0); } while (0)
#define ATT_DMA(j, slot) ATT_DMA_S(S, j, slot)
    if (!pre) {
#pragma unroll
        for (int d0 = 0; d0 < 4; ++d0) qr[d0] = *(const bf16x8*)(S.q + (size_t)r32 * 64 + d0 * 16 + hi * 8);
        ATT_DMA(0, 0); ATT_DMA(1, SLOTB); }
    f32x16 o1[2], o2[2];
#pragma unroll
    for (int d = 0; d < 2; ++d)
#pragma unroll
        for (int r = 0; r < 16; ++r) { o1[d][r] = 0.f; o2[d][r] = 0.f; }
    float l1 = 0.f, l2 = 0.f;
    const int koff = hi * 1024 + r32 * 16;
    const int voff = 8192 + ((lane >> 4) & 1) * 32 + (lane & 3) * 8 + (4 * hi + ((lane & 15) >> 2)) * 64;
    const unsigned lbase = (unsigned)(__SIZE_TYPE__)lds;
    f32x16 A0, B0, A1, B1; bf16x8 kA[4], kB[4];
    ATT_WAITV(0); ATT_BAR(); ATT_DMA(2, 2 * SLOTB); ATT_DMA(3, 3 * SLOTB);
#pragma unroll
    for (int d0 = 0; d0 < 4; ++d0) kA[d0] = *(const LAS bf16x8*)(lds + koff + d0 * 2048);
    dstep<false, true>(A0, B0, A1, B1, kA, kB, lds + koff + 512, 0u, qr, o1, o2, l1, l2);
    dstep<true, true>(A1, B1, A0, B0, kB, kA, lds + SLOTB + koff, lbase + voff, qr, o1, o2, l1, l2);
    int sl_prev = 0, sl_cur = SLOTB, sl_nxt = 2 * SLOTB, sl_n2 = 3 * SLOTB, sl_dma = 4 * SLOTB;
    for (int T = 1; T < NTR; ++T) {
        if (T + 2 <= NTR) ATT_WAITV(2); else ATT_WAITV(0);
        ATT_BAR();
        if (T + 3 <= NTR) ATT_DMA(T + 3, sl_dma);
        dstep<true, true>(A0, B0, A1, B1, kA, kB, lds + sl_cur + koff + 512, lbase + sl_prev + voff + 2048, qr, o1, o2, l1, l2);
        dstep<true, true>(A1, B1, A0, B0, kB, kA, lds + sl_nxt + koff, lbase + sl_cur + voff, qr, o1, o2, l1, l2);
        { const int f_ = sl_prev; sl_prev = sl_cur; sl_cur = sl_nxt; sl_nxt = sl_n2; sl_n2 = sl_dma; sl_dma = f_; }
    }
    ATT_WAITV(0); ATT_BAR();
    dstep<true, false>(A0, B0, A1, B1, kA, kB, lds, lbase + sl_prev + voff + 2048, qr, o1, o2, l1, l2);
#pragma unroll
    for (int r = 8; r < 16; ++r) { A0[r] = 0.f; B0[r] = 0.f; }
    {
        l1 += ((A0[0] + A0[1]) + (A0[2] + A0[3])) + ((A0[4] + A0[5]) + (A0[6] + A0[7])); l2 += ((B0[0] + B0[1]) + (B0[2] + B0[3])) + ((B0[4] + B0[5]) + (B0[6] + B0[7]));
        u32x4 wa, wb; wa.x = cvtpk(A0[0], A0[1]); wa.y = cvtpk(A0[2], A0[3]); wa.z = cvtpk(A0[4], A0[5]); wa.w = cvtpk(A0[6], A0[7]); wb.x = cvtpk(B0[0], B0[1]); wb.y = cvtpk(B0[2], B0[3]); wb.z = cvtpk(B0[4], B0[5]); wb.w = cvtpk(B0[6], B0[7]);
        const unsigned vpa = lbase + sl_cur + voff;
#pragma unroll
        for (int d0 = 0; d0 < 2; ++d0) { s16x4 ml, mh; ATT_TR(ml, vpa, d0 * 4096); ATT_TR(mh, vpa, d0 * 4096 + 512); ATT_LGKM0(); const bf16x8 vf = ATT_VF(ml, mh);
            o1[d0] = __builtin_amdgcn_mfma_f32_32x32x16_bf16(__builtin_bit_cast(bf16x8, wa), vf, o1[d0], 0, 0, 0); o2[d0] = __builtin_amdgcn_mfma_f32_32x32x16_bf16(__builtin_bit_cast(bf16x8, wb), vf, o2[d0], 0, 0, 0); } }
    ATT_BAR();
    bf16x8 qn[4];
    if (pn) {
#pragma unroll
        for (int d0 = 0; d0 < 4; ++d0) qn[d0] = *(const bf16x8*)(Sn.q + (size_t)r32 * 64 + d0 * 16 + hi * 8);
        ATT_DMA_S(Sn, 0, 0); ATT_DMA_S(Sn, 1, SLOTB); }
    l1 += shx(l1, 32, lane); l2 += shx(l2, 32, lane);
    LAS float* wsf = (LAS float*)(lds + WS_OFF + wid * 256);
    if (hi == 0) { wsf[r32] = 1.0f / l1; wsf[32 + r32] = lam / l2; }
    asm volatile("s_waitcnt lgkmcnt(0)" ::: "memory");
    LAS float* stg = (LAS float*)(lds + 2 * SLOTB + wid * STG_W);
#pragma unroll
    for (int r = 0; r < 16; ++r) { const int qrow = crow(r, hi); const float i1 = wsf[qrow], i2 = wsf[32 + qrow];
#pragma unroll
        for (int d0 = 0; d0 < 2; ++d0) stg[qrow * 68 + d0 * 32 + r32] = o1[d0][r] * i1 - o2[d0][r] * i2; }
    asm volatile("s_waitcnt lgkmcnt(0)" ::: "memory");
    { const int row = lane >> 1, hf = lane & 1; const LAS f32x4* src = (const LAS f32x4*)(stg + row * 68 + hf * 32); f32x4 v[8]; float ss = 0.f;
#pragma unroll
      for (int i = 0; i < 8; ++i) { v[i] = src[i]; ss += (v[i][0] * v[i][0] + v[i][1] * v[i][1]) + (v[i][2] * v[i][2] + v[i][3] * v[i][3]); }
      ss += shx(ss, 1, lane); const float sc = rsqrtf(ss * (1.0f / 64.0f) + 1e-5f) * 0.8f;
      bf16_t* dst = orow + (size_t)row * DM + hf * 32;
      const LAS float* gdh = (const LAS float*)(lds + GDH_OFF);
#pragma unroll
      for (int i = 0; i < 4; ++i) { const f32x4 a = v[2 * i] * sc * *(const LAS f32x4*)(gdh + hf * 32 + 8 * i), c = v[2 * i + 1] * sc * *(const LAS f32x4*)(gdh + hf * 32 + 8 * i + 4);
          u32x4 w; w.x = cvtpk(a[0], a[1]); w.y = cvtpk(a[2], a[3]); w.z = cvtpk(c[0], c[1]); w.w = cvtpk(c[2], c[3]); *(u32x4*)(dst + 8 * i) = w; } }
    if (pn) {
#pragma unroll
        for (int d0 = 0; d0 < 4; ++d0) qr[d0] = qn[d0]; }
    else ATT_BAR();
#undef ATT_DMA
#undef ATT_DMA_S
}

template <bool HAVE_PREV, bool HAVE_NEXT> __device__ __forceinline__ void sstep(f32x16& ca, f32x16& pa, const bf16x8 (&kf)[4], bf16x8 (&kn)[4], const LAS unsigned char* kbn, unsigned vpa,
                                                                const bf16x8 (&qr)[4], f32x16 (&o1)[2], float& l1, const bool full, const int dq  ) {
    const f32x16 z = {0.f, 0.f, 0.f, 0.f, 0.f, 0.f, 0.f, 0.f, 0.f, 0.f, 0.f, 0.f, 0.f, 0.f, 0.f, 0.f};
    s16x4 vl[2][2], vh[2][2]; u32x4 wa[2];
    ca = __builtin_amdgcn_mfma_f32_32x32x16_bf16(kf[0], qr[0], z, 0, 0, 0);
    float a0, a1, a2, a3, a4, a5, a6, a7;
    if (HAVE_PREV) { a0 = fadd_s(pa[0], pa[1]); a1 = fadd_s(pa[2], pa[3]); a2 = fadd_s(pa[4], pa[5]); a3 = fadd_s(pa[6], pa[7]); a4 = fadd_s(pa[8], pa[9]); a5 = fadd_s(pa[10], pa[11]); a6 = fadd_s(pa[12], pa[13]); a7 = fadd_s(pa[14], pa[15]);
        wa[0].x = cvtpk(pa[0], pa[1]); wa[0].y = cvtpk(pa[2], pa[3]); wa[0].z = cvtpk(pa[4], pa[5]); wa[0].w = cvtpk(pa[6], pa[7]); }
    ATT_SB();
    ca = __builtin_amdgcn_mfma_f32_32x32x16_bf16(kf[1], qr[1], ca, 0, 0, 0);
    if (HAVE_PREV) {
        ATT_TR(vl[0][0], vpa, 0); ATT_TR(vh[0][0], vpa, 512); ATT_TR(vl[1][0], vpa, 4096); ATT_TR(vh[1][0], vpa, 4096 + 512);
        ATT_TR(vl[0][1], vpa, 1024); ATT_TR(vh[0][1], vpa, 1024 + 512); ATT_TR(vl[1][1], vpa, 4096 + 1024); ATT_TR(vh[1][1], vpa, 4096 + 1024 + 512);
        a0 = fadd_s(a0, a1); a2 = fadd_s(a2, a3); a4 = fadd_s(a4, a5); a6 = fadd_s(a6, a7);
        wa[1].x = cvtpk(pa[8], pa[9]); wa[1].y = cvtpk(pa[10], pa[11]); wa[1].z = cvtpk(pa[12], pa[13]); wa[1].w = cvtpk(pa[14], pa[15]); }
    ATT_SB();
    ca = __builtin_amdgcn_mfma_f32_32x32x16_bf16(kf[2], qr[2], ca, 0, 0, 0);
    if (HAVE_PREV) { a0 = fadd_s(a0, a2); a4 = fadd_s(a4, a6); }
    ATT_SB();
    ca = __builtin_amdgcn_mfma_f32_32x32x16_bf16(kf[3], qr[3], ca, 0, 0, 0);
    if (HAVE_PREV) { a0 = fadd_s(a0, a4); l1 = fadd_s(l1, a0); }
    asm volatile("s_waitcnt lgkmcnt(0)" ::: "memory"); ATT_SB();
#define ATT_EX4(X, B) do { X[B] = __builtin_amdgcn_exp2f(X[B]); X[B + 1] = __builtin_amdgcn_exp2f(X[B + 1]); X[B + 2] = __builtin_amdgcn_exp2f(X[B + 2]); X[B + 3] = __builtin_amdgcn_exp2f(X[B + 3]); ATT_PIN(X); } while (0)
    if (HAVE_NEXT) { kn[0] = *(const LAS bf16x8*)(kbn); kn[1] = *(const LAS bf16x8*)(kbn + 2048); kn[2] = *(const LAS bf16x8*)(kbn + 4096); kn[3] = *(const LAS bf16x8*)(kbn + 6144); }
    if (HAVE_PREV) o1[0] = __builtin_amdgcn_mfma_f32_32x32x16_bf16(__builtin_bit_cast(bf16x8, wa[0]), ATT_VF(vl[0][0], vh[0][0]), o1[0], 0, 0, 0);
    if (!full) {
#pragma unroll
        for (int r = 0; r < 16; ++r) { const int d = dq - ((r & 3) + 8 * (r >> 2)); if (d > 128 || d < -128) ca[r] = -INFINITY; } }
    ATT_EX4(ca, 0); ATT_SB();
    if (HAVE_PREV) o1[1] = __builtin_amdgcn_mfma_f32_32x32x16_bf16(__builtin_bit_cast(bf16x8, wa[0]), ATT_VF(vl[1][0], vh[1][0]), o1[1], 0, 0, 0);
    ATT_EX4(ca, 4); ATT_SB();
    if (HAVE_PREV) o1[0] = __builtin_amdgcn_mfma_f32_32x32x16_bf16(__builtin_bit_cast(bf16x8, wa[1]), ATT_VF(vl[0][1], vh[0][1]), o1[0], 0, 0, 0);
    ATT_EX4(ca, 8); ATT_SB();
    if (HAVE_PREV) o1[1] = __builtin_amdgcn_mfma_f32_32x32x16_bf16(__builtin_bit_cast(bf16x8, wa[1]), ATT_VF(vl[1][1], vh[1][1]), o1[1], 0, 0, 0);
    ATT_EX4(ca, 12); ATT_SB();
#undef ATT_EX4
}
__device__ __forceinline__ void unit_swa(const P& p, LAS unsigned char* lds, const Src& S, const int qa  , const float sinkp, bf16_t* orow, const int wid,
                                         bf16x8 (&qr)[4], const bool pre, const bool pn, const Src& Sn) {
    const int lane = fresh_lane(), tid = wid * 64 + lane, r32 = lane & 31, hi = lane >> 5;
    const int NTR = S.ntr;
#define ATT_DMA_S(SS, j, slot) do { const bf16_t* ks_ = (j) < SS.ntr ? SS.k + (size_t)(SS.t0 + (j)) * TILE_EL : SS.km; const bf16_t* vs_ = (j) < SS.ntr ? SS.v + (size_t)(SS.t0 + (j)) * TILE_EL : SS.vm; \
        __builtin_amdgcn_global_load_lds((const unsigned*)(ks_ + tid * 8), (LAS unsigned*)(lds + (slot) + wid * 1024), 16, 0, 0); \
        __builtin_amdgcn_global_load_lds((const unsigned*)(vs_ + tid * 8), (LAS unsigned*)(lds + (slot) + 8192 + wid * 1024), 16, 0, 0); } while (0)
#define ATT_DMA(j, slot) ATT_DMA_S(S, j, slot)
    if (!pre) {
#pragma unroll
        for (int d0 = 0; d0 < 4; ++d0) qr[d0] = *(const bf16x8*)(S.q + (size_t)r32 * 64 + d0 * 16 + hi * 8);
        ATT_DMA(0, 0); ATT_DMA(1, SLOTB); }
    f32x16 o1[2];
#pragma unroll
    for (int d = 0; d < 2; ++d)
#pragma unroll
        for (int r = 0; r < 16; ++r) o1[d][r] = 0.f;
    float l1 = 0.f;
    const int koff = hi * 1024 + r32 * 16;
    const int voff = 8192 + ((lane >> 4) & 1) * 32 + (lane & 3) * 8 + (4 * hi + ((lane & 15) >> 2)) * 64;
    const unsigned lbase = (unsigned)(__SIZE_TYPE__)lds;
    const int k00 = 64 * S.t0;
#define SW_FULL(T, b) ((qa + 31 - (k00 + 64 * (T) + 32 * (b)) <= 128) && ((k00 + 64 * (T) + 32 * (b)) + 31 - qa <= 128))
#define SW_DQ(T, b) (qa + r32 - (k00 + 64 * (T) + 32 * (b)) - 4 * hi)
    f32x16 A0, A1; bf16x8 kA[4], kB[4];
    ATT_WAITV(0); ATT_BAR(); ATT_DMA(2, 2 * SLOTB); ATT_DMA(3, 3 * SLOTB);
#pragma unroll
    for (int d0 = 0; d0 < 4; ++d0) kA[d0] = *(const LAS bf16x8*)(lds + koff + d0 * 2048);
    sstep<false, true>(A0, A1, kA, kB, lds + koff + 512, 0u, qr, o1, l1, SW_FULL(0, 0), SW_DQ(0, 0));
    sstep<true, true>(A1, A0, kB, kA, lds + SLOTB + koff, lbase + voff, qr, o1, l1, SW_FULL(0, 1), SW_DQ(0, 1));
    int sl_prev = 0, sl_cur = SLOTB, sl_nxt = 2 * SLOTB, sl_n2 = 3 * SLOTB, sl_dma = 4 * SLOTB;
    for (int T = 1; T < NTR; ++T) {
        if (T + 2 <= NTR) ATT_WAITV(2); else ATT_WAITV(0);
        ATT_BAR();
        if (T + 3 <= NTR) ATT_DMA(T + 3, sl_dma);
        sstep<true, true>(A0, A1, kA, kB, lds + sl_cur + koff + 512, lbase + sl_prev + voff + 2048, qr, o1, l1, SW_FULL(T, 0), SW_DQ(T, 0));
        sstep<true, true>(A1, A0, kB, kA, lds + sl_nxt + koff, lbase + sl_cur + voff, qr, o1, l1, SW_FULL(T, 1), SW_DQ(T, 1));
        { const int f_ = sl_prev; sl_prev = sl_cur; sl_cur = sl_nxt; sl_nxt = sl_n2; sl_n2 = sl_dma; sl_dma = f_; }
    }
    ATT_WAITV(0); ATT_BAR();
    sstep<true, false>(A0, A1, kA, kB, lds, lbase + sl_prev + voff + 2048, qr, o1, l1, true, 0);
#undef SW_FULL
#undef SW_DQ
    {
        l1 += ((A0[0] + A0[1]) + (A0[2] + A0[3])) + ((A0[4] + A0[5]) + (A0[6] + A0[7]));
        u32x4 wa; wa.x = cvtpk(A0[0], A0[1]); wa.y = cvtpk(A0[2], A0[3]); wa.z = cvtpk(A0[4], A0[5]); wa.w = cvtpk(A0[6], A0[7]);
        const unsigned vpa = lbase + sl_cur + voff;
#pragma unroll
        for (int d0 = 0; d0 < 2; ++d0) { s16x4 ml, mh; ATT_TR(ml, vpa, d0 * 4096); ATT_TR(mh, vpa, d0 * 4096 + 512); ATT_LGKM0(); const bf16x8 vf = ATT_VF(ml, mh);
            o1[d0] = __builtin_amdgcn_mfma_f32_32x32x16_bf16(__builtin_bit_cast(bf16x8, wa), vf, o1[d0], 0, 0, 0); } }
    ATT_BAR();
    bf16x8 qn[4];
    if (pn) {
#pragma unroll
        for (int d0 = 0; d0 < 4; ++d0) qn[d0] = *(const bf16x8*)(Sn.q + (size_t)r32 * 64 + d0 * 16 + hi * 8);
        ATT_DMA_S(Sn, 0, 0); ATT_DMA_S(Sn, 1, SLOTB); }
    l1 += shx(l1, 32, lane); l1 += sinkp;
    LAS float* wsf = (LAS float*)(lds + WS_OFF + wid * 256);
    if (hi == 0) wsf[r32] = 1.0f / l1;
    asm volatile("s_waitcnt lgkmcnt(0)" ::: "memory");
    LAS float* stg = (LAS float*)(lds + 2 * SLOTB + wid * STG_W);
#pragma unroll
    for (int r = 0; r < 16; ++r) { const int qrow = crow(r, hi); const float i1 = wsf[qrow];
#pragma unroll
        for (int d0 = 0; d0 < 2; ++d0) stg[qrow * 68 + d0 * 32 + r32] = o1[d0][r] * i1; }
    asm volatile("s_waitcnt lgkmcnt(0)" ::: "memory");
    { const int row = lane >> 1, hf = lane & 1; const LAS f32x4* src = (const LAS f32x4*)(stg + row * 68 + hf * 32); bf16_t* dst = orow + (size_t)row * DM + hf * 32;
#pragma unroll
      for (int i = 0; i < 4; ++i) { const f32x4 a = src[2 * i], c = src[2 * i + 1];
          u32x4 w; w.x = cvtpk(a[0], a[1]); w.y = cvtpk(a[2], a[3]); w.z = cvtpk(c[0], c[1]); w.w = cvtpk(c[2], c[3]); *(u32x4*)(dst + 8 * i) = w; } }
    if (pn) {
#pragma unroll
        for (int d0 = 0; d0 < 4; ++d0) qr[d0] = qn[d0]; }
    else ATT_BAR();
#undef ATT_DMA
#undef ATT_DMA_S
}

__device__ __forceinline__ void phase(const P& p, LAS unsigned char* lds, int G, int vcu, const int wid) {
    const int lane = fresh_lane();
    const bf16_t* MT = (const bf16_t*)(p.ws + WS_META); bf16_t* MX = (bf16_t*)(p.ws + WS_MIXED);
    float sa = lane < 32 ? p.lq1[lane] * p.lk1[lane] : 0.f, sb = lane < 32 ? p.lq2[lane] * p.lk2[lane] : 0.f;
#pragma unroll
    for (int o = 1; o < 64; o <<= 1) { sa += shx(sa, o, lane); sb += shx(sb, o, lane); }
    const float lam = __expf(sa) - __expf(sb) + 0.2f;
    const int cslot = vcu & 15; int iter = 0;
    { LAS float* gdh = (LAS float*)(lds + GDH_OFF); if (wid == 0) gdh[lane] = p.g_dh[lane]; ATT_BAR(); }
    bf16x8 qrd[4]; bool pred = false;
#define ATT_DIFF_SRC(UU, SS, HH, TOK0, BB) const int qb_##SS = (UU) & 15, bh_##SS = (UU) >> 4; const int HH = bh_##SS & 7, BB = bh_##SS >> 3, TOK0 = qb_##SS * 256 + wid * 32; \
        const Src SS{(const bf16_t*)(p.ws + WS_QB) + ((size_t)bh_##SS * SEQ + TOK0) * 64, (const bf16_t*)(p.ws + WS_KB) + (size_t)bh_##SS * HEAD_EL, (const bf16_t*)(p.ws + WS_VB) + (size_t)bh_##SS * HEAD_EL, MT + (4 + HH) * TILE_EL, MT + (12 + HH) * TILE_EL, 0, 64}
    for (int U = vcu; U < NB * 8 * 16; U += G) {
        if (iter++ == cslot) { ATT_BAR(); f8_share(p, lds, G, vcu, wid); ATT_BAR(); }
        ATT_DIFF_SRC(U, S, h, tok0, b);
        const int Un = U + G; const bool pn = Un < NB * 8 * 16 && iter != cslot;
        ATT_DIFF_SRC(pn ? Un : U, Sn, hn, tok0n, bn);
        unit_diff(p, lds, S, lam, MX + ((size_t)b * SEQ + tok0) * DM + 512 + h * 64, wid, qrd, pred, pn, Sn);
        pred = pn;
    }
#undef ATT_DIFF_SRC
    bf16x8 qra[4]; bool pre = false;
#define ATT_SWA_SRC(UU, SS, HQ, TOK0, BB) const int gp_##SS = (UU) & 1, nq_##SS = ((UU) >> 1) & 31, bk_##SS = (UU) >> 6, kvh_##SS = bk_##SS & 1; const int BB = bk_##SS >> 1, HQ = kvh_##SS * 4 + gp_##SS * 2 + (wid >> 2), TOK0 = nq_##SS * 128 + (wid & 3) * 32; \
        const int tlo_##SS = 2 * nq_##SS - 2 < 0 ? 0 : 2 * nq_##SS - 2, thi_##SS = 2 * nq_##SS + 3 > 63 ? 63 : 2 * nq_##SS + 3; \
        const Src SS{(const bf16_t*)(p.ws + WS_QA) + ((size_t)(BB * 8 + HQ) * SEQ + TOK0) * 64, (const bf16_t*)(p.ws + WS_KA) + (size_t)bk_##SS * HEAD_EL, (const bf16_t*)(p.ws + WS_VA) + (size_t)bk_##SS * HEAD_EL, MT + kvh_##SS * TILE_EL, MT + (2 + kvh_##SS) * TILE_EL, tlo_##SS, thi_##SS - tlo_##SS + 1}
    for (int U = vcu; U < NB * 2 * 32 * 2; U += G) {
        if (iter++ == cslot) { ATT_BAR(); f8_share(p, lds, G, vcu, wid); ATT_BAR(); }
        ATT_SWA_SRC(U, S, hq, tok0, b);
        const int Un = U + G; const bool pn = Un < NB * 2 * 32 * 2 && iter != cslot;
        ATT_SWA_SRC(pn ? Un : U, Sn, hqn, tok0n, bn);
        unit_swa(p, lds, S, tok0, exp2f(p.sink[hq] * LOG2E), MX + ((size_t)b * SEQ + tok0) * DM + hq * 64, wid, qra, pre, pn, Sn);
        pre = pn;
    }
#undef ATT_SWA_SRC
    ATT_BAR();
    if (iter <= cslot) f8_share(p, lds, G, vcu, wid);
}
#undef ATT_WAITV
#undef ATT_BAR
}


struct Args { P p; int ph_lo, ph_hi; };
constexpr int NPHASE = 8;

struct Ctx { const P* pp; LAS unsigned char* lds; int G, bx, vcu, wave; unsigned* ctl; };

__device__ __forceinline__ void meta_task(const Ctx& c, int hs) {
    const P& p = *c.pp; const int hc = hs < 4 ? 8 + hs : 16 + hs, wave = c.wave, lane = fresh_lane(), tid = wave * 64 + lane;
    LAS float* xm = (LAS float*)(c.lds + RING_OFF); LAS float* part = (LAS float*)(c.lds + RING_OFF + 65536); LAS float* vout = (LAS float*)(c.lds + RING_OFF + 98304);
    bf16_t* tile = (bf16_t*)(p.ws + WS_META) + (hc < 10 ? hc - 8 : hc < 12 ? 2 + (hc - 10) : hc < 28 ? 4 + (hc - 20) : 12 + (hc - 28)) * TILE_EL;
    for (int i = tid; i < TILE_EL / 2; i += NWAVES * 64) ((unsigned*)tile)[i] = 0u;
    for (int rr = 0; rr < 2; ++rr) { const int row = 2 * wave + rr; const float* xr = p.meta + (size_t)row * DM; f32x4 v[4]; float s = 0.f;
#pragma unroll
        for (int j = 0; j < 4; ++j) { v[j] = ((const f32x4*)xr)[lane + 64 * j]; s += (v[j][0] * v[j][0] + v[j][1] * v[j][1]) + (v[j][2] * v[j][2] + v[j][3] * v[j][3]); }
#pragma unroll
        for (int o = 1; o < 64; o <<= 1) s += shx(s, o, lane);
        const float rs = rsqrtf(s * (1.0f / DM) + EPS);
#pragma unroll
        for (int j = 0; j < 4; ++j) { const f32x4 g = ((const f32x4*)p.g_attn)[lane + 64 * j]; ((LAS f32x4*)(xm + row * DM))[lane + 64 * j] = v[j] * rs * g; } }
    __syncthreads();
    { float acc[16];
#pragma unroll
      for (int r = 0; r < 16; ++r) acc[r] = 0.f;
      const float* wp = p.w_in + (size_t)(128 * wave) * INW + hc * 64 + lane;
      for (int k0 = 0; k0 < 128; k0 += 32) { float w[32];
#pragma unroll
          for (int k = 0; k < 32; ++k) w[k] = wp[(size_t)(k0 + k) * INW];
#pragma unroll
          for (int k = 0; k < 32; ++k) {
#pragma unroll
              for (int r = 0; r < 16; ++r) acc[r] += xm[r * DM + 128 * wave + k0 + k] * w[k]; } }
#pragma unroll
      for (int r = 0; r < 16; ++r) part[(wave * 16 + r) * 64 + lane] = acc[r]; }
    __syncthreads();
    for (int o = tid; o < 16 * 64; o += NWAVES * 64) { float s = 0.f;
#pragma unroll
        for (int kg = 0; kg < 8; ++kg) s += part[kg * 1024 + o];
        vout[o] = s; }
    __syncthreads();
    LAS float* csm = (LAS float*)(c.lds + RING_OFF + 65536);
    { const int pos = tid >> 5, f = tid & 31; const float ang = (float)pos * powf(10000.0f, -(float)(2 * f) / 64.0f); csm[2 * tid] = cosf(ang); csm[2 * tid + 1] = sinf(ang);
      if (tid < 256) { const int pos2 = tid >> 4, f2 = tid & 15; const float ang2 = (float)pos2 * powf(10000.0f, -(float)(2 * f2) / 32.0f); csm[1024 + 2 * tid] = cosf(ang2); csm[1024 + 2 * tid + 1] = sinf(ang2); } }
    __syncthreads();
    if (tid < 16) headpost(p, T + tid, hc, (float*)(vout + tid * 64), (const float2*)(float*)(csm + tid * 64), (const float2*)(float*)(csm + 1024 + tid * 32));
    __syncthreads();
}
__device__ __forceinline__ void ph0(const Ctx& c) {
    const P& p = *c.pp; const int wave = c.wave, G = c.G, vcu = c.vcu, lane = fresh_lane(), tid = wave * 64 + lane;
    if (vcu < 20) meta_task(c, vcu);
    if (vcu == 20) { bf16_t* wh = (bf16_t*)(p.ws + WS_WRT); bf16_t* wl = wh + NE * DM;
        for (int i = tid; i < NE * DM; i += NWAVES * 64) { const int k = i >> 5, e = i & 31; const float w = p.w_router[i]; const bf16_t h = f2bf(w); wh[e * DM + k] = h; wl[e * DM + k] = f2bf(w - bf2f(h)); } }
    LAS float* scr = (LAS float*)(c.lds + RING_OFF + wave * 16384);
    const int gw = vcu * NWAVES + wave, NGW = G * NWAVES;
    constexpr int I_IN = 16 * (INW / 32), I_OUT = 16 * 32;
    for (int it = gw; it < I_IN + I_OUT; it += NGW) {
        if (it < I_IN) p0_transpose_item<1>(p.w_in, INW, (bf16_t*)(p.ws + WS_WIN), scr, it, lane);
        else p0_transpose_item<0>(p.w_out, DM, (bf16_t*)(p.ws + WS_WOUT), scr, it - I_IN, lane);
    }
    bf16_t* XN = (bf16_t*)(p.ws + WS_MIXED);
    const int gwx = (vcu - 21) * NWAVES + wave, NGWX = (G - 21) * NWAVES;
    for (int m0 = (G > 42 ? gwx : gw) * 4; m0 < NROWS && (G <= 42 || vcu >= 21); m0 += (G > 42 ? NGWX : NGW) * 4) {
        f32x4 v[4][4];
#pragma unroll
        for (int r = 0; r < 4; ++r) { const int m = m0 + r < NROWS ? m0 + r : NROWS - 1; const float* xr = m < T ? p.x + (size_t)m * DM : p.meta + (size_t)(m - T) * DM;
#pragma unroll
            for (int j = 0; j < 4; ++j) v[r][j] = ((const f32x4*)xr)[lane + 64 * j]; }
#pragma unroll
        for (int r = 0; r < 4; ++r) { const int m = m0 + r; float s = 0.f;
#pragma unroll
            for (int j = 0; j < 4; ++j) s += (v[r][j][0] * v[r][j][0] + v[r][j][1] * v[r][j][1]) + (v[r][j][2] * v[r][j][2] + v[r][j][3] * v[r][j][3]);
#pragma unroll
            for (int o = 1; o < 64; o <<= 1) s += shx(s, o, lane);
            const float rs = rsqrtf(s * (1.0f / DM) + EPS);
            if (m < NROWS) {
#pragma unroll
                for (int j = 0; j < 4; ++j) { const f32x4 g = ((const f32x4*)p.g_attn)[lane + 64 * j]; const f32x4 y = v[r][j] * rs * g; u32x2 w; w.x = pk2(y[0], y[1]); w.y = pk2(y[2], y[3]); ((u32x2*)(XN + (size_t)m * DM))[lane + 64 * j] = w; } } }
    }
    if (vcu == 0 && tid < 48) { const int i = tid; const bool a64 = i < 32; const int f = a64 ? i : i - 32; const float inv = powf(10000.0f, -(float)(2 * f) / (a64 ? 64.0f : 32.0f)); const float ang = 16.0f * inv;
        ((float2*)(p.ws + WS_ROT))[i] = make_float2(cosf(ang), sinf(ang)); ((float*)(p.ws + WS_ROT))[96 + i] = inv * 0.15915494309189535f; }
}
__device__ __forceinline__ void ph1(const Ctx& c) {
    const P& p = *c.pp;
    pg8::RowOrder S; S.init(T, INW, c.G, c.bx, p.ws + WS_MIXED, p.ws + WS_WIN);
    pg8::EpiQKV E{c.pp};
    { const int t = c.wave * 64 + fresh_lane(); LAS float* tab = (LAS float*)(c.lds + TAB_EPI);
      if (t < 336) tab[t] = t < 64 ? p.g_q_swa[t] : t < 128 ? p.g_k_swa[t - 64] : t < 160 ? p.g_q_diff[t - 128] : t < 192 ? p.g_k_diff[t - 160] : ((const float*)(p.ws + WS_ROT))[t - 192];
      __syncthreads(); }
    pg8::gemm_phase<pg8::EpiQKV, pg8::RowOrder>(c.lds + RING_OFF, S, E, c.wave);
}
__device__ __forceinline__ void ph2(const Ctx& c) { att::phase(*c.pp, c.lds + RING_OFF, c.G, c.vcu, c.wave); }
__device__ __forceinline__ void ph3(const Ctx& c) {
    const P& p = *c.pp;
    pg8::RowOrder S; S.init(T, DM, c.G, c.bx, p.ws + WS_MIXED, p.ws + WS_WOUT);
    pg8::EpiO E{(bf16_t*)p.out};
    pg8::gemm_phase<pg8::EpiO, pg8::RowOrder>(c.lds + RING_OFF, S, E, c.wave);
}
constexpr int R_AP = 2064;
constexpr int R_AH = 0, R_AL = 16 * R_AP, R_PART = 32 * R_AP, R_HIST = R_PART + 16384, R_SEL = R_HIST + 256, R_GATE = R_SEL + 4096;
static_assert(R_GATE + 4096 <= RING_BYTES, "router LDS");
struct RRows { f32x4 x[2][4]; u32x2 o[2][4]; };
__device__ __forceinline__ void r_load(const P& p, RRows& r, int tok0, int lane) {
#pragma unroll
    for (int rr = 0; rr < 2; ++rr) { const f32x4* xr = (const f32x4*)(p.x + (size_t)(tok0 + rr) * DM); const u32x2* orow = (const u32x2*)((const bf16_t*)p.out + (size_t)(tok0 + rr) * 2048);
#pragma unroll
        for (int j = 0; j < 4; ++j) { r.x[rr][j] = xr[lane + 64 * j]; r.o[rr][j] = orow[lane + 64 * j]; } }
}
__device__ __forceinline__ void r_tile(const Ctx& c, const RRows& r, int tokw  , int slot0  , const f32x4 (&gq)[4], const bf16x8 (&bh)[4][2], const bf16x8 (&bl)[4][2], float bias) {
    const P& p = *c.pp; const int wave = c.wave, lane = fresh_lane(); LAS unsigned char* L = c.lds + RING_OFF;
    unsigned char* V = p.ws + WS_V;
#pragma unroll
    for (int rr = 0; rr < 2; ++rr) { f32x4 h[4]; float s = 0.f;
#pragma unroll
        for (int j = 0; j < 4; ++j) { const u32x2 w = r.o[rr][j]; h[j] = r.x[rr][j] + (f32x4){__uint_as_float(w.x << 16), __uint_as_float(w.x & 0xffff0000u), __uint_as_float(w.y << 16), __uint_as_float(w.y & 0xffff0000u)};
            s += (h[j][0] * h[j][0] + h[j][1] * h[j][1]) + (h[j][2] * h[j][2] + h[j][3] * h[j][3]); }
        s = allsum64(s);
        const float rs = rsqrtf(s * (1.0f / DM) + EPS);
#pragma unroll
        for (int j = 0; j < 4; ++j) { u32x2 hb; hb.x = pg8::cvt_pk_bf16(h[j][0], h[j][1]); hb.y = pg8::cvt_pk_bf16(h[j][2], h[j][3]); ((u32x2*)((bf16_t*)p.out + (size_t)(tokw + rr) * 2048))[lane + 64 * j] = hb; }
#pragma unroll
        for (int j = 0; j < 4; ++j) { const f32x4 v = h[j] * rs * gq[j]; u32x2 wh, wl; wh.x = pg8::cvt_pk_bf16(v[0], v[1]); wh.y = pg8::cvt_pk_bf16(v[2], v[3]);
            const f32x4 d = v - (f32x4){__uint_as_float(wh.x << 16), __uint_as_float(wh.x & 0xffff0000u), __uint_as_float(wh.y << 16), __uint_as_float(wh.y & 0xffff0000u)};
            wl.x = pg8::cvt_pk_bf16(d[0], d[1]); wl.y = pg8::cvt_pk_bf16(d[2], d[3]);
            ((unsigned*)(V + (size_t)(tokw + rr) * DM))[lane + 64 * j] = pg8::pk4_fp8(8.0f * v[0], 8.0f * v[1], 8.0f * v[2], 8.0f * v[3]);
            *(LAS u32x2*)(L + R_AH + (2 * wave + rr) * R_AP + (lane + 64 * j) * 8) = wh; *(LAS u32x2*)(L + R_AL + (2 * wave + rr) * R_AP + (lane + 64 * j) * 8) = wl; } }
    __syncthreads();
    f32x4 acc[2], ahh[2], ahl[2], alh[2];
#pragma unroll
    for (int eb = 0; eb < 2; ++eb) { ahh[eb] = (f32x4){0.f, 0.f, 0.f, 0.f}; ahl[eb] = ahh[eb]; alh[eb] = ahh[eb]; }
#pragma unroll
    for (int s = 0; s < 4; ++s) { const int off = (lane & 15) * R_AP + (128 * wave + 32 * s + 8 * (lane >> 4)) * 2;
        const bf16x8 ah = *(const LAS bf16x8*)(L + R_AH + off), al = *(const LAS bf16x8*)(L + R_AL + off);
#pragma unroll
        for (int eb = 0; eb < 2; ++eb) { ahh[eb] = __builtin_amdgcn_mfma_f32_16x16x32_bf16(ah, bh[s][eb], ahh[eb], 0, 0, 0); ahl[eb] = __builtin_amdgcn_mfma_f32_16x16x32_bf16(ah, bl[s][eb], ahl[eb], 0, 0, 0);
            alh[eb] = __builtin_amdgcn_mfma_f32_16x16x32_bf16(al, bh[s][eb], alh[eb], 0, 0, 0); } }
#pragma unroll
    for (int eb = 0; eb < 2; ++eb) acc[eb] = ahh[eb] + (ahl[eb] + alh[eb]);
    LAS float* part = (LAS float*)(L + R_PART);
#pragma unroll
    for (int eb = 0; eb < 2; ++eb)
#pragma unroll
        for (int q = 0; q < 4; ++q) part[(wave * 16 + (lane >> 4) * 4 + q) * 32 + 16 * eb + (lane & 15)] = acc[eb][q];
    __syncthreads();
    const int tl = 2 * wave + (lane >> 5), e = lane & 31; float lg = bias;
#pragma unroll
    for (int w = 0; w < 8; ++w) lg += part[(w * 16 + tl) * 32 + e];
    float cur = lg, tv0 = 0.f, tv1 = 0.f, tv2 = 0.f, tv3 = 0.f; int ti0 = 0, ti1 = 0, ti2 = 0, ti3 = 0;
#pragma unroll
    for (int k = 0; k < TOPK; ++k) {
        const float bv = allmax32(cur); const unsigned long long mk = __builtin_amdgcn_ballot_w64(cur == bv);
        const int i0 = (int)__builtin_ctzll(mk | (1ull << 32)), i1 = (int)__builtin_ctzll((mk >> 32) | (1ull << 32)); const int bi = (lane >> 5) ? i1 : i0;
        if (k == 0) { tv0 = bv; ti0 = bi; } if (k == 1) { tv1 = bv; ti1 = bi; } if (k == 2) { tv2 = bv; ti2 = bi; } if (k == 3) { tv3 = bv; ti3 = bi; }
        if (e == bi) cur = -INFINITY; }
    const float e1 = __expf(tv1 - tv0), e2 = __expf(tv2 - tv0), e3 = __expf(tv3 - tv0); const float inv = 1.0f / (1.0f + e1 + e2 + e3);
    if (e < 4) { const int sel = e == 0 ? ti0 : e == 1 ? ti1 : e == 2 ? ti2 : ti3; const float gg = (e == 0 ? 1.0f : e == 1 ? e1 : e == 2 ? e2 : e3) * inv;
        LAS int* lsel = (LAS int*)(L + R_SEL); LAS float* lgate = (LAS float*)(L + R_GATE); LAS int* lhist = (LAS int*)(L + R_HIST);
        lsel[(slot0 + tl) * 4 + e] = sel; lgate[(slot0 + tl) * 4 + e] = gg; atomicAdd((int*)(lhist + sel), 1); }
}
__device__ __forceinline__ void ph4(const Ctx& c) {
    const P& p = *c.pp; const int wave = c.wave, lane = fresh_lane(), tid = wave * 64 + lane; LAS unsigned char* L = c.lds + RING_OFF;
    LAS int* lhist = (LAS int*)(L + R_HIST); LAS int* lbase = lhist + 32; LAS int* lsel = (LAS int*)(L + R_SEL); LAS float* lgate = (LAS float*)(L + R_GATE);
    unsigned* counts = c.ctl + CW_COUNT;
    bf16x8 bh[4][2], bl[4][2]; f32x4 gq[4];
    { const bf16_t* wh = (const bf16_t*)(p.ws + WS_WRT); const bf16_t* wl = wh + NE * DM;
#pragma unroll
      for (int s = 0; s < 4; ++s)
#pragma unroll
          for (int eb = 0; eb < 2; ++eb) { const size_t o = (size_t)(16 * eb + (lane & 15)) * DM + 128 * wave + 32 * s + 8 * (lane >> 4); bh[s][eb] = *(const bf16x8*)(wh + o); bl[s][eb] = *(const bf16x8*)(wl + o); }
#pragma unroll
      for (int j = 0; j < 4; ++j) gq[j] = ((const f32x4*)p.g_ffn)[lane + 64 * j]; }
    const float bias = p.b_router[lane & 31];
    for (int ch = c.bx; ch < T / 256; ch += c.G) {
        const int t0 = ch * 256;
        if (tid < NE) lhist[tid] = 0;
        RRows ra, rb; r_load(p, ra, t0 + 2 * wave, lane);
        for (int tile = 0; tile < 16; tile += 2) {
            r_load(p, rb, t0 + 16 * (tile + 1) + 2 * wave, lane);
            r_tile(c, ra, t0 + 16 * tile + 2 * wave, 16 * tile, gq, bh, bl, bias);
            if (tile + 2 < 16) r_load(p, ra, t0 + 16 * (tile + 2) + 2 * wave, lane);
            r_tile(c, rb, t0 + 16 * (tile + 1) + 2 * wave, 16 * (tile + 1), gq, bh, bl, bias);
        }
        __syncthreads();
        if (tid < NE) { lbase[tid] = (int)atomicAdd(&counts[tid], (unsigned)lhist[tid]); lhist[tid] = 0; }
        __syncthreads();
        int* extok = (int*)(p.ws + WS_EXTOK); float* exgate = (float*)(p.ws + WS_EXGATE);
        for (int i = tid; i < 256 * 4; i += NWAVES * 64) { const int e = lsel[i]; const int pos = lbase[e] + atomicAdd((int*)(lhist + e), 1);
            extok[e * 65536 + pos] = (t0 + (i >> 2)) * 4 + (i & 3); exgate[e * 65536 + pos] = lgate[i]; }
        __syncthreads();
    }
}
__device__ __forceinline__ int moe_tables(const Ctx& c) {
    LAS int* pstart = (LAS int*)(c.lds + TAB_PSTART); LAS int* cnts = (LAS int*)(c.lds + TAB_CNT); LAS unsigned char* pexp = (LAS unsigned char*)(c.lds + TAB_PEXP);
    const int tid_ = c.wave * 64 + fresh_lane();
    __syncthreads();
    if (c.wave == 0) {
        const int l_ = tid_; const int cc = l_ < NE ? (int)__hip_atomic_load(c.ctl + CW_COUNT + l_, RLX_AGENT) : 0; const int np = (cc + 255) >> 8; int inc = np;
#pragma unroll
        for (int o = 1; o < NE; o <<= 1) { const int t = __builtin_amdgcn_ds_bpermute(((l_ - o) & 63) << 2, inc); if (l_ >= o) inc += t; }
        if (l_ < NE) { cnts[l_] = cc; pstart[l_] = inc - np; if (l_ == NE - 1) pstart[NE] = inc; } }
    __syncthreads();
    const int npan = pstart[NE];
    for (int pnl = tid_; pnl < npan; pnl += NWAVES * 64) { int e = 0;
#pragma unroll
        for (int st = 16; st >= 1; st >>= 1) if (pstart[e + st] <= pnl) e += st;
        pexp[pnl] = (unsigned char)e; }
    __syncthreads();
    return __builtin_amdgcn_readfirstlane(npan);
}
__device__ __forceinline__ void ph5(const Ctx& c) {
    const P& p = *c.pp; const int npan = moe_tables(c);
    LAS int* pstart = (LAS int*)(c.lds + TAB_PSTART); LAS int* cnts = (LAS int*)(c.lds + TAB_CNT); LAS unsigned char* pexp = (LAS unsigned char*)(c.lds + TAB_PEXP);
    pg8::MoeOrder<8, true> S{c.G, c.vcu, npan, (const char*)(p.ws + WS_V), (const char*)(p.ws + WS_W1T), (size_t)2048 * DM, (const int*)(p.ws + WS_EXTOK), pstart, cnts, pexp};
    pg8::EpiSwiglu E{p.b1, p.ws + WS_ACT};
    pg8::gemm_phase<pg8::EpiSwiglu, pg8::MoeOrder<8, true>>(c.lds + RING_OFF, S, E, c.wave);
}
__device__ __forceinline__ void ph6(const Ctx& c) {
    const P& p = *c.pp; const int npan = moe_tables(c);
    LAS int* pstart = (LAS int*)(c.lds + TAB_PSTART); LAS int* cnts = (LAS int*)(c.lds + TAB_CNT); LAS unsigned char* pexp = (LAS unsigned char*)(c.lds + TAB_PEXP);
    pg8::MoeOrder<4, false> S{c.G, c.vcu, npan, (const char*)(p.ws + WS_ACT), (const char*)(p.ws + WS_W2T), (size_t)DM * DM, (const int*)(p.ws + WS_EXTOK), pstart, cnts, pexp};
    pg8::EpiMoe2 E{p.b2, (const int*)(p.ws + WS_EXTOK), (const float*)(p.ws + WS_EXGATE), (unsigned char*)p.out, p.ws + WS_YS3};
    pg8::gemm_phase<pg8::EpiMoe2, pg8::MoeOrder<4, false>>(c.lds + RING_OFF, S, E, c.wave);
}
struct R7 { u32x4 h0, h1v, y[4]; };
__device__ __forceinline__ void p7_load(const P& p, int t, int lane, R7& r) {
    const unsigned char* row = (const unsigned char*)p.out + (size_t)t * 4096; const unsigned char* ys = p.ws + WS_YS3;
    r.h0 = *(const u32x4*)(row + 32 * lane); r.h1v = *(const u32x4*)(row + 32 * lane + 16); r.y[0] = *(const u32x4*)(row + 2048 + 16 * lane);
#pragma unroll
    for (int k = 0; k < 3; ++k) r.y[k + 1] = *(const u32x4*)(ys + ((size_t)t * 3 + k) * DM + 16 * lane);
}
__device__ __forceinline__ void p7_finish(const P& p, int t, int lane, const R7& r) {
    float o[16];
#pragma unroll
    for (int q = 0; q < 4; ++q) { o[2 * q] = __uint_as_float(r.h0[q] << 16); o[2 * q + 1] = __uint_as_float(r.h0[q] & 0xffff0000u); o[8 + 2 * q] = __uint_as_float(r.h1v[q] << 16); o[8 + 2 * q + 1] = __uint_as_float(r.h1v[q] & 0xffff0000u); }
#pragma unroll
    for (int q = 0; q < 4; ++q) { float s0 = 0.f, s1 = 0.f, s2 = 0.f, s3 = 0.f;
#pragma unroll
        for (int k = 0; k < 4; ++k) { const auto lo = __builtin_amdgcn_cvt_pk_f32_fp8((int)r.y[k][q], false), hi = __builtin_amdgcn_cvt_pk_f32_fp8((int)r.y[k][q], true); s0 += lo[0]; s1 += lo[1]; s2 += hi[0]; s3 += hi[1]; }
        o[4 * q] += s0 * (1.0f / 64.0f); o[4 * q + 1] += s1 * (1.0f / 64.0f); o[4 * q + 2] += s2 * (1.0f / 64.0f); o[4 * q + 3] += s3 * (1.0f / 64.0f); }
    asm volatile("" ::: "memory");
    f32x4* dst = (f32x4*)(p.out + (size_t)t * DM + 16 * lane);
#pragma unroll
    for (int q = 0; q < 4; ++q) dst[q] = (f32x4){o[4 * q], o[4 * q + 1], o[4 * q + 2], o[4 * q + 3]};
}
__device__ __forceinline__ void ph7(const Ctx& c) {
    const P& p = *c.pp; const int gw = c.bx * NWAVES + c.wave, NGW = c.G * NWAVES, lane = fresh_lane();
    R7 a, b; int t = gw;
    if (t < T) p7_load(p, t, lane, a);
    while (t < T) {
        const int t1 = t + NGW; if (t1 < T) p7_load(p, t1, lane, b);
        p7_finish(p, t, lane, a);
        if (t1 >= T) break;
        const int t2 = t1 + NGW; if (t2 < T) p7_load(p, t2, lane, a);
        p7_finish(p, t1, lane, b);
        t = t2;
    }
}
struct EpiNull8 { static constexpr bool PERM = true; static constexpr bool HAS_PREFETCH = false; static constexpr unsigned SCALE_W = 0x7c7c7c7cu, SCALE_A = 0x7c7c7c7cu;
    __device__ __forceinline__ void operator()(const f32x4 (&acc)[2][2][4][2], const pg8::Unit&, int, int, int, int) const {
#pragma unroll
        for (int a = 0; a < 2; ++a)
#pragma unroll
            for (int b = 0; b < 2; ++b)
#pragma unroll
                for (int m = 0; m < 4; ++m)
#pragma unroll
                    for (int n = 0; n < 2; ++n) asm volatile("" :: "v"(acc[a][b][m][n])); } };
__device__ __forceinline__ void ph5null(const Ctx& c) {
    const P& p = *c.pp; const int npan = moe_tables(c);
    LAS int* pstart = (LAS int*)(c.lds + TAB_PSTART); LAS int* cnts = (LAS int*)(c.lds + TAB_CNT); LAS unsigned char* pexp = (LAS unsigned char*)(c.lds + TAB_PEXP);
    pg8::MoeOrder<8, true> S{c.G, c.vcu, npan, (const char*)(p.ws + WS_V), (const char*)(p.ws + WS_W1T), (size_t)2048 * DM, (const int*)(p.ws + WS_EXTOK), pstart, cnts, pexp};
    EpiNull8 E; pg8::gemm_phase<EpiNull8, pg8::MoeOrder<8, true>>(c.lds + RING_OFF, S, E, c.wave);
}
__device__ __forceinline__ void ph6null(const Ctx& c) {
    const P& p = *c.pp; const int npan = moe_tables(c);
    LAS int* pstart = (LAS int*)(c.lds + TAB_PSTART); LAS int* cnts = (LAS int*)(c.lds + TAB_CNT); LAS unsigned char* pexp = (LAS unsigned char*)(c.lds + TAB_PEXP);
    pg8::MoeOrder<4, false> S{c.G, c.vcu, npan, (const char*)(p.ws + WS_ACT), (const char*)(p.ws + WS_W2T), (size_t)DM * DM, (const int*)(p.ws + WS_EXTOK), pstart, cnts, pexp};
    EpiNull8 E; pg8::gemm_phase<EpiNull8, pg8::MoeOrder<4, false>>(c.lds + RING_OFF, S, E, c.wave);
}
#ifndef PROBE_REP
#define PROBE_REP -1
#endif

__global__ void __launch_bounds__(NWAVES * 64, 2) mk_fwd(Args args) {
    extern __shared__ __attribute__((aligned(16))) unsigned char lds_raw[];
    Ctx c; c.pp = &args.p; c.lds = (LAS unsigned char*)lds_raw;
    c.wave = __builtin_amdgcn_readfirstlane((int)(threadIdx.x >> 6));
    c.G = gridDim.x; c.bx = blockIdx.x; c.vcu = (c.G % 8 == 0) ? (c.bx % 8) * (c.G / 8) + c.bx / 8 : c.bx;
    c.ctl = (unsigned*)(args.p.ws + WS_CTL);
    for (int u = c.wave * 64 + fresh_lane(); u < (LDS_BYTES - LDSCTL_OFF) / 4; u += NWAVES * 64) ((LAS unsigned*)(c.lds + LDSCTL_OFF))[u] = 0u;
    __syncthreads();
    const int lo = args.ph_lo, hi = args.ph_hi;
    XcdBarrier bar; bar.bar = c.ctl + CW_BAR; bar.x = 0; bar.st = nullptr; bar.wave = c.wave;
    if (hi - lo > 1) bar = xcd_barrier_post(c.ctl + CW_BAR, (volatile LAS unsigned*)(c.lds + MISC_OFF) + 8, c.wave);
#define IN(k) (lo <= (k) && (k) < hi)
#define SEAM(k) do { if (IN(k) && IN((k) + 1)) xcd_barrier(bar); } while (0)
#define PH(k, f) do { if (IN(k)) { f(c); if (PROBE_REP == (k)) { __syncthreads(); f(c); } } } while (0)
#if PROBE_REP == 100
    if (IN(1)) { { pg8::RowOrder S; S.init(T, INW, c.G, c.bx, args.p.ws + WS_MIXED, args.p.ws + WS_WIN); pg8::EpiNull<true> E; pg8::gemm_phase<pg8::EpiNull<true>, pg8::RowOrder>(c.lds + RING_OFF, S, E, c.wave); }
                 { pg8::RowOrder S; S.init(T, DM, c.G, c.bx, args.p.ws + WS_MIXED, args.p.ws + WS_WOUT); pg8::EpiNull<false> E; pg8::gemm_phase<pg8::EpiNull<false>, pg8::RowOrder>(c.lds + RING_OFF, S, E, c.wave); } __syncthreads(); }
#endif
    PH(0, ph0); SEAM(0);
    PH(1, ph1); SEAM(1);
    PH(2, ph2); SEAM(2);
    PH(3, ph3); SEAM(3);
    PH(4, ph4); SEAM(4);
#if PROBE_REP == 101
    if (IN(5)) { ph5null(c); __syncthreads(); }
#endif
#if PROBE_REP == 102
    if (IN(5)) { ph6null(c); __syncthreads(); }
#endif
    PH(5, ph5); SEAM(5);
    PH(6, ph6); SEAM(6);
    PH(7, ph7);
#undef IN
#undef SEAM
#undef PH
}

extern "C" void kernel_launch(void* const* d_in, const int* in_sizes, int n_in, void* d_out, int out_size, void* d_ws, size_t ws_size, hipStream_t stream) {
    static int grid = 0;
    if (grid == 0) {
        if (n_in != 22 || out_size != T * DM || ws_size < WS_END) { fprintf(stderr, "kernel_launch: unexpected shapes (n_in %d out %d ws %zu)\n", n_in, out_size, ws_size); grid = -1; return; }
        int dev = 0, cus = 0, per_cu = 0;
        if (hipGetDevice(&dev) != hipSuccess || hipDeviceGetAttribute(&cus, hipDeviceAttributeMultiprocessorCount, dev) != hipSuccess) { grid = -1; return; }
        if (hipFuncSetAttribute((const void*)mk_fwd, hipFuncAttributeMaxDynamicSharedMemorySize, LDS_BYTES) != hipSuccess) { fprintf(stderr, "kernel_launch: hipFuncSetAttribute failed\n"); grid = -1; return; }
        if (hipOccupancyMaxActiveBlocksPerMultiprocessor(&per_cu, (const void*)mk_fwd, NWAVES * 64, LDS_BYTES) != hipSuccess || per_cu < 1) fprintf(stderr, "kernel_launch: occupancy query says %d\n", per_cu);
        (void)hipGetLastError();
        grid = cus;
    }
    if (grid < 0) return;
    Args a{};
    const float** f = (const float**)&a.p;
    for (int i = 0; i < 22; ++i) f[i] = (const float*)d_in[i];
    a.p.out = (float*)d_out; a.p.ws = (unsigned char*)d_ws;
    const P& p = a.p;
    (void)hipMemsetAsync((char*)d_ws + WS_CTL, 0, 32768, stream);
#define MK(lo_, hi_) do { a.ph_lo = (lo_); a.ph_hi = (hi_); hipLaunchKernelGGL(mk_fwd, dim3(grid), dim3(NWAVES * 64), LDS_BYTES, stream, a); } while (0)
#if ONE_LAUNCH
    MK(0, NPHASE);
#else
    MK(0, 1);
#if OPT_INPROJ
    MK(1, 2);
#else
    hipLaunchKernelGGL(k_rstd, dim3((NROWS + 3) / 4), dim3(256), 0, stream, p);
    hipLaunchKernelGGL(k_inproj_naive, dim3((NROWS + 63) / 64, 36), dim3(256), 0, stream, p);
#endif
#if OPT_ATTN
    MK(2, 3);
#else
    hipLaunchKernelGGL(k_swa_naive, dim3(NB * 8 * SEQ / 256), dim3(256), 0, stream, p);
    hipLaunchKernelGGL(k_diff_naive, dim3(NB * 8 * 16), dim3(256), 0, stream, p);
#endif
#if 1
    MK(3, 4);
#else
    hipLaunchKernelGGL(k_sgemm<0>, dim3(T / 64, DM / 64), dim3(256), 0, stream, p);
#endif
#if 1
    MK(4, 5);
#else
    hipLaunchKernelGGL(k_route, dim3(T / 64), dim3(256), 0, stream, p);
#endif
#if 1
    MK(5, 6); MK(6, 7);
#else
    hipLaunchKernelGGL(k_sgemm<1>, dim3((T * 4 + NE * 255 + 63) / 64 + 4, DFF / 64), dim3(256), 0, stream, p);
    hipLaunchKernelGGL(k_sgemm<2>, dim3((T * 4 + NE * 255 + 63) / 64 + 4, DM / 64), dim3(256), 0, stream, p);
#endif
#if 1
    MK(7, 8);
#else
    hipLaunchKernelGGL(k_combine, dim3(T * DM / 4 / 256), dim3(256), 0, stream, p);
#endif
#endif
#undef MK
}
```

```cpp
#include <hip/hip_runtime.h>
#include <cstdint>
#include <cstdio>

typedef unsigned short bf16_t;
__device__ __forceinline__ float bf2f(bf16_t b) { return __uint_as_float(((unsigned)b) << 16); }
__device__ __forceinline__ bf16_t f2bf(float f) { unsigned u = __float_as_uint(f); u += 0x7fffu + ((u >> 16) & 1u); return (bf16_t)(u >> 16); }

constexpr int NB = 16, SEQ = 4096, DM = 1024, T = NB * SEQ, NMETA = 16, LPOS = SEQ + NMETA;
constexpr int INW = 2304, NE = 32, TOPK = 4, DFF = 1024;
constexpr int NROWS = T + NMETA;
constexpr float EPS = 1e-6f;
constexpr float LOG2E = 1.4426950408889634f;
constexpr float QSCALE_A = 0.125f * LOG2E;
constexpr float QSCALE_B = 0.17677669529663687f * LOG2E;
constexpr int TILE_EL = 4096;
constexpr int HEAD_EL = SEQ * 64;

constexpr size_t MiB = 1u << 20;
constexpr size_t WS_CTL = 0, CTL_BYTES = 1 * MiB;
constexpr size_t WS_CS64 = 1 * MiB;
constexpr size_t WS_CS32 = 3 * MiB;
constexpr size_t WS_ROT = 3 * MiB + 640 * 1024;
constexpr size_t WS_META = 3 * MiB + 768 * 1024;
constexpr size_t WS_WIN = 4 * MiB, WS_WOUT = 9 * MiB;
constexpr size_t WS_RSTD = 11 * MiB;
constexpr size_t WS_WRT = 11 * MiB + 512 * 1024;
constexpr size_t WS_EXTOK = 12 * MiB, WS_EXGATE = 20 * MiB;
constexpr size_t WS_W2T = 32 * MiB;
constexpr size_t WS_ACT = 96 * MiB;
constexpr size_t WS_QA = WS_ACT, WS_KA = WS_QA + (size_t)NB * 8 * HEAD_EL * 2, WS_VA = WS_KA + (size_t)NB * 2 * HEAD_EL * 2;
constexpr size_t WS_QB = WS_VA + (size_t)NB * 2 * HEAD_EL * 2, WS_KB = WS_QB + (size_t)NB * 8 * HEAD_EL * 2, WS_VB = WS_KB + (size_t)NB * 8 * HEAD_EL * 2;
constexpr size_t WS_X = 624 * MiB;
constexpr size_t WS_W1T = WS_X, WS_V = WS_X + 128 * MiB, WS_MIXED = WS_X + 256 * MiB;
constexpr size_t WS_XB = 400 * MiB;
constexpr size_t WS_YS3 = WS_X;
constexpr size_t WS_END = 1024 * MiB;
static_assert(WS_VB + (size_t)NB * 8 * HEAD_EL * 2 <= WS_XB && WS_XB + (size_t)T * DM * 2 <= WS_X, "qkv / xb fit");
constexpr int CW_COUNT = 64;

struct P {
    const float *x, *meta, *g_attn, *w_in, *g_q_swa, *g_k_swa, *g_q_diff, *g_k_diff, *sink, *lq1, *lk1, *lq2, *lk2, *g_dh, *w_out, *g_ffn, *w_router, *b_router, *w1, *b1, *w2, *b2;
    float* out; unsigned char* ws;
};

__host__ __device__ __forceinline__ int ktile_off(int tok, int d) { return (tok >> 6) * TILE_EL + (d >> 3) * 512 + (tok & 63) * 8 + (d & 7); }
__host__ __device__ __forceinline__ int vtile_off(int tok, int d) { return (tok >> 6) * TILE_EL + (d >> 5) * 2048 + ((tok & 63) >> 4) * 512 + (tok & 15) * 32 + (d & 31); }

__host__ __device__ __forceinline__ int bslot(int dp) { return 8 * ((dp & 15) >> 2) + 4 * (dp >> 4) + (dp & 3); }
__global__ void k_tables(P p) {
    float2* cs64 = (float2*)(p.ws + WS_CS64); float2* cs32 = (float2*)(p.ws + WS_CS32);
    const int i = blockIdx.x * blockDim.x + threadIdx.x;
    if (i < LPOS * 32) { const int pos = i >> 5, f = i & 31; const float inv = powf(10000.0f, -(float)(2 * f) / 64.0f); const float ang = (float)pos * inv; cs64[i] = make_float2(cosf(ang), sinf(ang)); }
    if (i < LPOS * 16) { const int pos = i >> 4, f = i & 15; const float inv = powf(10000.0f, -(float)(2 * f) / 32.0f); const float ang = (float)pos * inv; cs32[i] = make_float2(cosf(ang), sinf(ang)); }
    if (i < 20 * TILE_EL / 2) ((unsigned*)(p.ws + WS_META))[i] = 0u;
}
__global__ void k_rstd(P p) {
    const int row = blockIdx.x * (blockDim.x >> 6) + (threadIdx.x >> 6), lane = threadIdx.x & 63;
    if (row >= NROWS) return;
    const float* xr = row < T ? p.x + (size_t)row * DM : p.meta + (size_t)(row - T) * DM;
    float s = 0.f;
    for (int j = 0; j < 4; ++j) { const float4 v = ((const float4*)xr)[lane + 64 * j]; s += v.x * v.x + v.y * v.y + v.z * v.z + v.w * v.w; }
    for (int o = 1; o < 64; o <<= 1) s += __shfl_xor(s, o);
    if (lane == 0) ((float*)(p.ws + WS_RSTD))[row] = rsqrtf(s * (1.0f / DM) + EPS);
}

__device__ __forceinline__ void headpost(const P& p, int r, int hc, float* v, const float2* cs64, const float2* cs32) {
    const bool meta = r >= T; const int b = r >> 12, tok = r & 4095, pos = meta ? r - T : tok + NMETA;
    bf16_t* QA = (bf16_t*)(p.ws + WS_QA); bf16_t* KA = (bf16_t*)(p.ws + WS_KA); bf16_t* VA = (bf16_t*)(p.ws + WS_VA);
    bf16_t* QB = (bf16_t*)(p.ws + WS_QB); bf16_t* KB = (bf16_t*)(p.ws + WS_KB); bf16_t* VB = (bf16_t*)(p.ws + WS_VB);
    bf16_t* MT = (bf16_t*)(p.ws + WS_META);
    if (hc < 10) {
        if (hc < 8 && meta) return;
        const float* g = hc < 8 ? p.g_q_swa : p.g_k_swa;
        float ss = 0.f; for (int d = 0; d < 64; ++d) ss += v[d] * v[d];
        const float rs = rsqrtf(ss * (1.0f / 64.0f) + EPS);
        for (int d = 0; d < 64; ++d) v[d] = v[d] * rs * g[d];
        for (int i = 0; i < 32; ++i) { const float2 cs = cs64[i]; const float a = v[i], c = v[i + 32]; v[i] = a * cs.x - c * cs.y; v[i + 32] = c * cs.x + a * cs.y; }
        if (hc < 8) { bf16_t* q = QA + ((size_t)(b * 8 + hc) * SEQ + tok) * 64; for (int d = 0; d < 64; ++d) q[d] = f2bf(v[d] * QSCALE_A); }
        else { const int kvh = hc - 8; bf16_t* k = meta ? MT + kvh * TILE_EL : KA + (size_t)(b * 2 + kvh) * HEAD_EL; const int tk = meta ? pos : tok; for (int d = 0; d < 64; ++d) k[ktile_off(tk, d)] = f2bf(v[d]); }
    } else if (hc < 12) {
        const int kvh = hc - 10; bf16_t* vv = meta ? MT + (2 + kvh) * TILE_EL : VA + (size_t)(b * 2 + kvh) * HEAD_EL; const int tk = meta ? pos : tok;
        for (int d = 0; d < 64; ++d) vv[vtile_off(tk, d)] = f2bf(v[d]);
    } else if (hc < 28) {
        const bool isq = hc < 20; if (isq && meta) return;
        const float* g = isq ? p.g_q_diff : p.g_k_diff;
        for (int hf = 0; hf < 2; ++hf) { float* w = v + 32 * hf;
            float ss = 0.f; for (int d = 0; d < 32; ++d) ss += w[d] * w[d];
            const float rs = rsqrtf(ss * (1.0f / 32.0f) + EPS);
            for (int d = 0; d < 32; ++d) w[d] = w[d] * rs * g[d];
            for (int i = 0; i < 16; ++i) { const float2 cs = cs32[i]; const float a = w[i], c = w[i + 16]; w[i] = a * cs.x - c * cs.y; w[i + 16] = c * cs.x + a * cs.y; } }
        if (isq) { const int h = hc - 12; bf16_t* q = QB + ((size_t)(b * 8 + h) * SEQ + tok) * 64; for (int d = 0; d < 64; ++d) q[(d & 32) + bslot(d & 31)] = f2bf(v[d] * QSCALE_B); }
        else { const int h = hc - 20; bf16_t* k = meta ? MT + (4 + h) * TILE_EL : KB + (size_t)(b * 8 + h) * HEAD_EL; const int tk = meta ? pos : tok; for (int d = 0; d < 64; ++d) k[ktile_off(tk, (d & 32) + bslot(d & 31))] = f2bf(v[d]); }
    } else {
        const int h = hc - 28; bf16_t* vv = meta ? MT + (12 + h) * TILE_EL : VB + (size_t)(b * 8 + h) * HEAD_EL; const int tk = meta ? pos : tok;
        for (int d = 0; d < 64; ++d) vv[vtile_off(tk, d)] = f2bf(v[d]);
    }
}

__global__ __launch_bounds__(256) void k_inproj_naive(P p) {
    __shared__ float As[16][68], Bs[16][68], Ct[64][65];
    const int tid = threadIdx.x, tx = tid & 15, ty = tid >> 4, r0 = blockIdx.x * 64, hc = blockIdx.y;
    const float* rstd = (const float*)(p.ws + WS_RSTD);
    float acc[4][4] = {};
    for (int k0 = 0; k0 < DM; k0 += 16) {
        for (int i = 0; i < 4; ++i) { const int idx = tid + i * 256, rr = idx >> 4, kk = idx & 15, r = r0 + rr; float a = 0.f;
            if (r < NROWS) { const float* xr = r < T ? p.x + (size_t)r * DM : p.meta + (size_t)(r - T) * DM; a = xr[k0 + kk] * rstd[r] * p.g_attn[k0 + kk]; }
            As[kk][rr] = a; }
        for (int i = 0; i < 4; ++i) { const int idx = tid + i * 256, kk = idx >> 6, cc = idx & 63; Bs[kk][cc] = p.w_in[(size_t)(k0 + kk) * INW + hc * 64 + cc]; }
        __syncthreads();
        for (int kk = 0; kk < 16; ++kk) { float a[4], bb[4];
            for (int i = 0; i < 4; ++i) a[i] = As[kk][ty * 4 + i];
            for (int j = 0; j < 4; ++j) bb[j] = Bs[kk][tx * 4 + j];
            for (int i = 0; i < 4; ++i) for (int j = 0; j < 4; ++j) acc[i][j] += a[i] * bb[j]; }
        __syncthreads();
    }
    for (int i = 0; i < 4; ++i) for (int j = 0; j < 4; ++j) Ct[ty * 4 + i][tx * 4 + j] = acc[i][j];
    __syncthreads();
    if (tid < 64) { const int r = r0 + tid; if (r < NROWS) { const int pos = r >= T ? r - T : (r & 4095) + NMETA; headpost(p, r, hc, &Ct[tid][0], (const float2*)(p.ws + WS_CS64) + pos * 32, (const float2*)(p.ws + WS_CS32) + pos * 16); } }
}

__global__ __launch_bounds__(256) void k_swa_naive(P p) {
    const int gid = blockIdx.x * 256 + threadIdx.x; const int tok = gid & 4095, bh = gid >> 12, hq = bh & 7, b = bh >> 3, kvh = hq >> 2;
    const bf16_t* QA = (const bf16_t*)(p.ws + WS_QA) + ((size_t)bh * SEQ + tok) * 64;
    const bf16_t* KA = (const bf16_t*)(p.ws + WS_KA) + (size_t)(b * 2 + kvh) * HEAD_EL; const bf16_t* VA = (const bf16_t*)(p.ws + WS_VA) + (size_t)(b * 2 + kvh) * HEAD_EL;
    const bf16_t* MT = (const bf16_t*)(p.ws + WS_META); const bf16_t* KM = MT + kvh * TILE_EL; const bf16_t* VM = MT + (2 + kvh) * TILE_EL;
    float q[64], o[64]; for (int d = 0; d < 64; ++d) { q[d] = bf2f(QA[d]); o[d] = 0.f; }
    float l = exp2f(p.sink[hq] * LOG2E);
    for (int k = 0; k < NMETA; ++k) { float s = 0.f; for (int d = 0; d < 64; ++d) s += q[d] * bf2f(KM[ktile_off(k, d)]); const float pr = exp2f(s); l += pr; for (int d = 0; d < 64; ++d) o[d] += pr * bf2f(VM[vtile_off(k, d)]); }
    const int k0 = tok - 128 < 0 ? 0 : tok - 128, k1 = tok + 128 > SEQ - 1 ? SEQ - 1 : tok + 128;
    for (int k = k0; k <= k1; ++k) { float s = 0.f; for (int d = 0; d < 64; ++d) s += q[d] * bf2f(KA[ktile_off(k, d)]); const float pr = exp2f(s); l += pr; for (int d = 0; d < 64; ++d) o[d] += pr * bf2f(VA[vtile_off(k, d)]); }
    bf16_t* mx = (bf16_t*)(p.ws + WS_MIXED) + ((size_t)b * SEQ + tok) * DM + hq * 64; const float il = 1.0f / l;
    for (int d = 0; d < 64; ++d) mx[d] = f2bf(o[d] * il);
}
__global__ __launch_bounds__(256) void k_diff_naive(P p) {
    __shared__ float Ks[64][64]; __shared__ float Vs[64][64];
    const int unit = blockIdx.x, qb = unit & 15, bh = unit >> 4, h = bh & 7, b = bh >> 3, tid = threadIdx.x, tok = qb * 256 + tid;
    const bf16_t* QB = (const bf16_t*)(p.ws + WS_QB) + ((size_t)bh * SEQ + tok) * 64;
    const bf16_t* KB = (const bf16_t*)(p.ws + WS_KB) + (size_t)bh * HEAD_EL; const bf16_t* VB = (const bf16_t*)(p.ws + WS_VB) + (size_t)bh * HEAD_EL;
    const bf16_t* MT = (const bf16_t*)(p.ws + WS_META);
    float q[64], o1[64], o2[64]; for (int d = 0; d < 64; ++d) { q[d] = bf2f(QB[d]); o1[d] = 0.f; o2[d] = 0.f; }
    float l1 = 0.f, l2 = 0.f;
    for (int t = 0; t < 65; ++t) {
        const bf16_t* kt = t < 64 ? KB + t * TILE_EL : MT + (4 + h) * TILE_EL; const bf16_t* vt = t < 64 ? VB + t * TILE_EL : MT + (12 + h) * TILE_EL; const int nk = t < 64 ? 64 : NMETA;
        __syncthreads();
        for (int i = 0; i < 16; ++i) { const int e = tid + i * 256;
            Ks[(e >> 3) & 63][(e >> 9) * 8 + (e & 7)] = bf2f(kt[e]);
            Vs[((e >> 9) & 3) * 16 + ((e >> 5) & 15)][(e >> 11) * 32 + (e & 31)] = bf2f(vt[e]); }
        __syncthreads();
        for (int k = 0; k < nk; ++k) { float s1 = 0.f, s2 = 0.f;
            for (int d = 0; d < 32; ++d) { s1 += q[d] * Ks[k][d]; s2 += q[32 + d] * Ks[k][32 + d]; }
            const float p1 = exp2f(s1), p2 = exp2f(s2); l1 += p1; l2 += p2;
            for (int d = 0; d < 64; ++d) { const float vv = Vs[k][d]; o1[d] += p1 * vv; o2[d] += p2 * vv; } }
    }
    float sa = 0.f, sb = 0.f; for (int d = 0; d < 32; ++d) { sa += p.lq1[d] * p.lk1[d]; sb += p.lq2[d] * p.lk2[d]; }
    const float lam = expf(sa) - expf(sb) + 0.2f; const float i1 = 1.0f / l1, i2 = lam / l2;
    float ss = 0.f; for (int d = 0; d < 64; ++d) { o1[d] = o1[d] * i1 - o2[d] * i2; ss += o1[d] * o1[d]; }
    const float rs = rsqrtf(ss * (1.0f / 64.0f) + 1e-5f) * 0.8f;
    bf16_t* mx = (bf16_t*)(p.ws + WS_MIXED) + ((size_t)b * SEQ + tok) * DM + 512 + h * 64;
    for (int d = 0; d < 64; ++d) mx[d] = f2bf(o1[d] * rs * p.g_dh[d]);
}

__device__ __forceinline__ void expert_of_panel(const unsigned* counts, int panel, int& e, int& pos0, int& cnt) {
    int ps = 0; e = -1; pos0 = 0; cnt = 0;
    for (int i = 0; i < NE; ++i) { const int c = (int)counts[i], np = (c + 255) >> 8; if (panel < ps + np) { e = i; pos0 = (panel - ps) * 256; cnt = c; return; } ps += np; }
}

template <int MODE> __global__ __launch_bounds__(256) void k_sgemm(P p) {
    __shared__ float As[16][68], Bs[16][68], Bs2[16][68];
    __shared__ int rowtok[64]; __shared__ float rowgate[64];
    const int tid = threadIdx.x, tx = tid & 15, ty = tid >> 4, r0 = blockIdx.x * 64, c0 = blockIdx.y * 64;
    const unsigned* counts = (const unsigned*)(p.ws + WS_CTL) + CW_COUNT;
    int e = 0, pos0 = 0, cnt = 0;
    if (MODE != 0) { expert_of_panel(counts, blockIdx.x >> 2, e, pos0, cnt); if (e < 0) return; pos0 += (blockIdx.x & 3) * 64;
        if (tid < 64) { const int pos = pos0 + tid; const bool ok = pos < cnt; rowtok[tid] = ok ? ((const int*)(p.ws + WS_EXTOK))[e * 65536 + pos] : -1; rowgate[tid] = ok ? ((const float*)(p.ws + WS_EXGATE))[e * 65536 + pos] : 0.f; }
        __syncthreads(); }
    const bf16_t* Amix = (const bf16_t*)(p.ws + WS_MIXED); const bf16_t* Av = (const bf16_t*)(p.ws + WS_V); const bf16_t* Aact = (const bf16_t*)(p.ws + WS_ACT);
    float acc[4][4] = {}, acc2[4][4] = {};
    for (int k0 = 0; k0 < DM; k0 += 16) {
        for (int i = 0; i < 4; ++i) { const int idx = tid + i * 256, rr = idx >> 4, kk = idx & 15; float a = 0.f;
            if (MODE == 0) a = bf2f(Amix[(size_t)(r0 + rr) * DM + k0 + kk]);
            if (MODE == 1) { const int tk = rowtok[rr]; a = tk >= 0 ? bf2f(Av[(size_t)(tk >> 2) * DM + k0 + kk]) : 0.f; }
            if (MODE == 2) a = bf2f(Aact[(size_t)(r0 + rr) * DM + k0 + kk]);
            As[kk][rr] = a; }
        for (int i = 0; i < 4; ++i) { const int idx = tid + i * 256, kk = idx >> 6, cc = idx & 63;
            if (MODE == 0) Bs[kk][cc] = p.w_out[(size_t)(k0 + kk) * DM + c0 + cc];
            if (MODE == 1) { const float* w = p.w1 + (size_t)e * DM * 2048 + (size_t)(k0 + kk) * 2048 + c0 + cc; Bs[kk][cc] = w[0]; Bs2[kk][cc] = w[1024]; }
            if (MODE == 2) Bs[kk][cc] = p.w2[(size_t)e * DM * DM + (size_t)(k0 + kk) * DM + c0 + cc]; }
        __syncthreads();
        for (int kk = 0; kk < 16; ++kk) { float a[4], bb[4], b2[4];
            for (int i = 0; i < 4; ++i) a[i] = As[kk][ty * 4 + i];
            for (int j = 0; j < 4; ++j) { bb[j] = Bs[kk][tx * 4 + j]; if (MODE == 1) b2[j] = Bs2[kk][tx * 4 + j]; }
            for (int i = 0; i < 4; ++i) for (int j = 0; j < 4; ++j) { acc[i][j] += a[i] * bb[j]; if (MODE == 1) acc2[i][j] += a[i] * b2[j]; } }
        __syncthreads();
    }
    for (int i = 0; i < 4; ++i) for (int j = 0; j < 4; ++j) { const int rr = ty * 4 + i, r = r0 + rr, c = c0 + tx * 4 + j;
        if (MODE == 0) p.out[(size_t)r * DM + c] = p.x[(size_t)r * DM + c] + acc[i][j];
        if (MODE == 1) { float glu = acc[i][j] + p.b1[e * 2048 + c], lin = acc2[i][j] + p.b1[e * 2048 + 1024 + c];
            glu = fminf(glu, 7.0f); lin = fminf(fmaxf(lin, -7.0f), 7.0f);
            const float a = glu * (1.0f / (1.0f + __expf(-1.702f * glu))) * (lin + 1.0f);
            ((bf16_t*)(p.ws + WS_ACT))[(size_t)r * DM + c] = f2bf(a); }
        if (MODE == 2) { const int tk = rowtok[rr]; if (tk >= 0) { const float y = (acc[i][j] + p.b2[e * DM + c]) * rowgate[rr]; const int tok = tk >> 2, k = tk & 3;
            if (k == 0) p.out[(size_t)tok * DM + c] += y; else ((bf16_t*)(p.ws + WS_YS3))[((size_t)tok * 3 + (k - 1)) * DM + c] = f2bf(y); } }
    }
}

template <bool OH> __device__ __forceinline__ void route_block(const P& p, int t0, int ntok, int* lhist  , int* lbase  , int* lsel  , float* lgate  , float* lrow  ) {
    const int tid = threadIdx.x, lane = tid & 63, wid = tid >> 6, nw = blockDim.x >> 6;
    unsigned* counts = (unsigned*)(p.ws + WS_CTL) + CW_COUNT;
    if (tid < NE) lhist[tid] = 0;
    __syncthreads();
    bf16_t* V = (bf16_t*)(p.ws + WS_V);
    for (int it = wid; it < ntok; it += nw) {
        const int tok = t0 + it; const float* hr = OH ? p.x + (size_t)tok * DM : p.out + (size_t)tok * DM;
        float4 v[4]; float s = 0.f;
        for (int j = 0; j < 4; ++j) { v[j] = ((const float4*)hr)[lane + 64 * j];
            if (OH) { const uint2 w = ((const uint2*)((const bf16_t*)p.out + (size_t)tok * 2048))[lane + 64 * j];
                v[j].x += __uint_as_float(w.x << 16); v[j].y += __uint_as_float(w.x & 0xffff0000u); v[j].z += __uint_as_float(w.y << 16); v[j].w += __uint_as_float(w.y & 0xffff0000u); }
            s += v[j].x * v[j].x + v[j].y * v[j].y + v[j].z * v[j].z + v[j].w * v[j].w; }
        for (int o = 1; o < 64; o <<= 1) s += __shfl_xor(s, o);
        const float rs = rsqrtf(s * (1.0f / DM) + EPS);
        for (int j = 0; j < 4; ++j) { const float4 g = ((const float4*)p.g_ffn)[lane + 64 * j]; v[j].x *= rs * g.x; v[j].y *= rs * g.y; v[j].z *= rs * g.z; v[j].w *= rs * g.w;
            ushort4 w; w.x = f2bf(v[j].x); w.y = f2bf(v[j].y); w.z = f2bf(v[j].z); w.w = f2bf(v[j].w); ((ushort4*)(V + (size_t)tok * DM))[lane + 64 * j] = w; }
        float* row = lrow + wid * DM;
#pragma unroll
        for (int j = 0; j < 4; ++j) ((float4*)row)[lane + 64 * j] = v[j];
        __builtin_amdgcn_fence(__ATOMIC_RELEASE, "workgroup"); __builtin_amdgcn_wave_barrier();
        float acc = 0.f; { const int e = lane & 31, kb = (lane >> 5) * 512; const float* wr = p.w_router + (size_t)kb * NE + e;
#pragma unroll 8
            for (int k = 0; k < 512; ++k) acc += row[kb + k] * wr[(size_t)k * NE]; }
        acc += __shfl_xor(acc, 32);
        __builtin_amdgcn_wave_barrier();
        const float mylogit = lane < NE ? acc + p.b_router[lane] : -INFINITY;
        float cur = mylogit; float tv0 = 0.f, tv1 = 0.f, tv2 = 0.f, tv3 = 0.f; int ti0 = 0, ti1 = 0, ti2 = 0, ti3 = 0;
#pragma unroll
        for (int k = 0; k < TOPK; ++k) { float bv = cur; int bi = lane;
#pragma unroll
            for (int o = 1; o < 64; o <<= 1) { const float ov = __shfl_xor(bv, o); const int oi = __shfl_xor(bi, o); if (ov > bv || (ov == bv && oi < bi)) { bv = ov; bi = oi; } }
            if (k == 0) { tv0 = bv; ti0 = bi; } if (k == 1) { tv1 = bv; ti1 = bi; } if (k == 2) { tv2 = bv; ti2 = bi; } if (k == 3) { tv3 = bv; ti3 = bi; }
            if (lane == bi) cur = -INFINITY; }
        const float e0 = 1.0f, e1 = __expf(tv1 - tv0), e2 = __expf(tv2 - tv0), e3 = __expf(tv3 - tv0); const float inv = 1.0f / (e0 + e1 + e2 + e3);
        if (lane < 4) { const int sel = lane == 0 ? ti0 : lane == 1 ? ti1 : lane == 2 ? ti2 : ti3; const float gg = (lane == 0 ? e0 : lane == 1 ? e1 : lane == 2 ? e2 : e3) * inv;
            lsel[it * 4 + lane] = sel; lgate[it * 4 + lane] = gg; atomicAdd(&lhist[sel], 1); }
    }
    __syncthreads();
    if (tid < NE) { lbase[tid] = (int)atomicAdd(&counts[tid], (unsigned)lhist[tid]); lhist[tid] = 0; }
    __syncthreads();
    int* extok = (int*)(p.ws + WS_EXTOK); float* exgate = (float*)(p.ws + WS_EXGATE);
    for (int i = tid; i < ntok * 4; i += blockDim.x) { const int e = lsel[i]; const int pos = lbase[e] + atomicAdd(&lhist[e], 1);
        extok[e * 65536 + pos] = (t0 + (i >> 2)) * 4 + (i & 3); exgate[e * 65536 + pos] = lgate[i]; }
    __syncthreads();
}
__global__ __launch_bounds__(256) void k_route(P p) {
    __shared__ int lhist[32], lbase[32], lsel[64 * 4]; __shared__ float lgate[64 * 4]; __shared__ float lrow[4 * DM];
    route_block<false>(p, blockIdx.x * 64, 64, lhist, lbase, lsel, lgate, lrow);
}
__global__ __launch_bounds__(256) void k_combine(P p) {
    const size_t i = (size_t)blockIdx.x * 256 + threadIdx.x;
    const size_t tok = i >> 8, c4 = i & 255; const bf16_t* ys = (const bf16_t*)(p.ws + WS_YS3) + tok * 3 * DM + c4 * 4;
    float4 o = ((float4*)p.out)[i];
    for (int k = 0; k < 3; ++k) { const ushort4 w = *(const ushort4*)(ys + (size_t)k * DM); o.x += bf2f(w.x); o.y += bf2f(w.y); o.z += bf2f(w.z); o.w += bf2f(w.w); }
    ((float4*)p.out)[i] = o;
}


#define LAS __attribute__((address_space(3)))
#define GAS __attribute__((address_space(1)))
typedef short bf16x8 __attribute__((ext_vector_type(8)));
typedef float f32x4 __attribute__((ext_vector_type(4)));
typedef unsigned u32x4 __attribute__((ext_vector_type(4)));
typedef unsigned u32x2 __attribute__((ext_vector_type(2)));
typedef int v4i_t __attribute__((ext_vector_type(4)));
typedef int v8i_t __attribute__((ext_vector_type(8)));

#ifndef OPT_INPROJ
#define OPT_INPROJ 1
#endif
#ifndef OPT_ATTN
#define OPT_ATTN 1
#endif
#ifndef OPT_OUTPROJ
#define OPT_OUTPROJ 1
#endif
#ifndef OPT_ROUTE
#define OPT_ROUTE 1
#endif
#ifndef OPT_MOE
#define OPT_MOE 1
#endif
#ifndef OPT_COMBINE
#define OPT_COMBINE 1
#endif
#ifndef ONE_LAUNCH
#define ONE_LAUNCH 1
#endif

constexpr int RING_OFF = 0, RING_BYTES = 131072;
constexpr int LDSCTL_OFF = RING_BYTES, MISC_OFF = LDSCTL_OFF + 320;
constexpr int TAB_OFF = LDSCTL_OFF + 512;
constexpr int TAB_PSTART = TAB_OFF, TAB_CNT = TAB_OFF + 160, TAB_PEXP = TAB_OFF + 320, TAB_GOFF = TAB_OFF + 2048;
constexpr int LDS_BYTES = 151552;
constexpr int TAB_EPI = TAB_GOFF + 8192, EP_BUF = 3072;
static_assert(TAB_PEXP + 1280 <= TAB_GOFF && TAB_EPI + 2 * EP_BUF <= LDS_BYTES, "LDS map");
constexpr int NWAVES = 8;
constexpr int CW_BAR = 4096;

__device__ __forceinline__ int fresh_lane() { unsigned z = 0u; asm volatile("" : "+v"(z)); return (int)__builtin_amdgcn_mbcnt_hi(~0u, __builtin_amdgcn_mbcnt_lo(~0u, z)); }
__device__ __forceinline__ float shx(float v, int m, int lane) { return __int_as_float(__builtin_amdgcn_ds_bpermute((lane ^ m) << 2, __float_as_int(v))); }
__device__ __forceinline__ int shxi(int v, int m, int lane) { return __builtin_amdgcn_ds_bpermute((lane ^ m) << 2, v); }
template <int CTRL> __device__ __forceinline__ float dppf(float v) { return __int_as_float(__builtin_amdgcn_mov_dpp(__float_as_int(v), CTRL, 0xf, 0xf, true)); }
__device__ __forceinline__ float allsum32(float s) {
    s += dppf<0xB1>(s); s += dppf<0x4E>(s); s += dppf<0x141>(s); s += dppf<0x140>(s);
    const auto r = __builtin_amdgcn_permlane16_swap((unsigned)__float_as_int(s), (unsigned)__float_as_int(s), false, false);
    return __int_as_float((int)r[0]) + __int_as_float((int)r[1]); }
__device__ __forceinline__ float sum4rows(float s) {
    const auto r = __builtin_amdgcn_permlane16_swap((unsigned)__float_as_int(s), (unsigned)__float_as_int(s), false, false); s = __int_as_float((int)r[0]) + __int_as_float((int)r[1]);
    const auto q = __builtin_amdgcn_permlane32_swap((unsigned)__float_as_int(s), (unsigned)__float_as_int(s), false, false); return __int_as_float((int)q[0]) + __int_as_float((int)q[1]); }
__device__ __forceinline__ float allsum64(float s) { s = allsum32(s);
    const auto q = __builtin_amdgcn_permlane32_swap((unsigned)__float_as_int(s), (unsigned)__float_as_int(s), false, false);
    return __int_as_float((int)q[0]) + __int_as_float((int)q[1]); }
__device__ __forceinline__ float allmax32(float s) {
    s = fmaxf(s, dppf<0xB1>(s)); s = fmaxf(s, dppf<0x4E>(s)); s = fmaxf(s, dppf<0x141>(s)); s = fmaxf(s, dppf<0x140>(s));
    const auto r = __builtin_amdgcn_permlane16_swap((unsigned)__float_as_int(s), (unsigned)__float_as_int(s), false, false);
    return fmaxf(__int_as_float((int)r[0]), __int_as_float((int)r[1])); }
namespace pg8 {
constexpr int BM = 256, BK = 64, HALF = 128, HTB = HALF * BK * 2, STAGE_BYTES = 8 * HTB, NXCD = 8, WGM = 8, K = 1024;
__host__ __device__ __forceinline__ int lds_byte(int r, int c) { const int st = (r >> 4) * 2 + (c >> 5), rr = r & 15, cc = c & 31, ob = rr * 64 + cc * 2; return st * 1024 + (ob ^ (((ob >> 9) & 1) << 5)); }
__host__ __device__ __forceinline__ void stage_rc(int b, int& R, int& C) { const int st = b / 1024, sb = b % 1024, swz = sb ^ (((sb >> 9) & 1) << 5); R = (st >> 1) * 16 + swz / 64; C = (st & 1) * 32 + (swz % 64) / 2; }
__host__ __device__ __forceinline__ int perm32(int rho) { const int n = rho >> 4, i = rho & 15; return 8 * (i >> 2) + 4 * n + (i & 3); }
__device__ __forceinline__ unsigned cvt_pk_bf16(float lo, float hi) { unsigned r; asm volatile("v_cvt_pk_bf16_f32 %0, %1, %2" : "=v"(r) : "v"(lo), "v"(hi)); return r; }

struct Unit { int pm, pn, e, pos0, cnt; };

template <int PITCH_> struct RowOrderT {
    static constexpr int PITCH = PITCH_;
    static constexpr bool GATHERS = false;
    int nM, nN, nwg, G, c; const char* A; const char* Bt;
    __device__ void init(int M, int N, int G_, int c_, const void* A_, const void* Bt_) { nM = M / BM; nN = N / BM; nwg = nM * nN; G = G_; c = c_; A = (const char*)A_; Bt = (const char*)Bt_; }
    __device__ __forceinline__ bool next(int i, Unit& u) const {
        const long L = (long)i * G + c; if (L >= nwg) return false;
        int wgid = (int)L; { const int q = nwg / NXCD, r = nwg % NXCD, xcd = wgid % NXCD, off = wgid / NXCD; wgid = (xcd < r ? xcd * (q + 1) : r * (q + 1) + (xcd - r) * q) + off; }
        const int nig = WGM * nN, gid = wgid / nig, fm = gid * WGM, gsz = (nM - fm) < WGM ? (nM - fm) : WGM;
        u.pm = fm + ((wgid % nig) % gsz); u.pn = (wgid % nig) / gsz; u.e = 0; u.pos0 = 0; u.cnt = 0; return true;
    }
    __device__ __forceinline__ const char* aptr(const Unit& u) const { return A + (size_t)u.pm * (BM * PITCH); }
    __device__ __forceinline__ const char* bptr(const Unit& u) const { return Bt + (size_t)u.pn * (BM * PITCH); }
    __device__ __forceinline__ void a_offsets(const Unit&, int, unsigned (&)[2][2]) const {}
};
typedef RowOrderT<K * 2> RowOrder; typedef RowOrderT<K> RowOrder8;
template <int NC, bool GATHER> struct MoeOrder {
    static constexpr int PITCH = K;
    static constexpr bool GATHERS = GATHER;
    int G, vcu, npan; const char* A; const char* Bt; size_t estride; const int* extok;
    const LAS int* pstart; const LAS int* cnts; const LAS unsigned char* pexp;
    __device__ __forceinline__ bool next(int i, Unit& u) const {
        const int U = i * G + vcu, panel = U / NC; if (panel >= npan) return false;
        const int e = __builtin_amdgcn_readfirstlane((int)pexp[panel]);
        u.pm = panel; u.pn = U % NC; u.e = e; u.pos0 = (panel - __builtin_amdgcn_readfirstlane(pstart[e])) * 256; u.cnt = __builtin_amdgcn_readfirstlane(cnts[e]); return true;
    }
    __device__ __forceinline__ const char* aptr(const Unit& u) const { return GATHER ? A : A + (size_t)u.pm * (BM * PITCH); }
    __device__ __forceinline__ const char* bptr(const Unit& u) const { return Bt + (size_t)u.e * estride + (size_t)u.pn * (BM * PITCH); }
    __device__ __forceinline__ void a_offsets(const Unit& u, int wid, unsigned (&o)[2][2]) const {
        int R0, C0; stage_rc((wid * 64 + fresh_lane()) * 16, R0, C0);
#pragma unroll
        for (int h = 0; h < 2; ++h)
#pragma unroll
            for (int i = 0; i < 2; ++i) {
                if (GATHER) { int pos = u.pos0 + R0 + 64 * i + 128 * h; pos = pos < u.cnt ? pos : u.cnt - 1; const int tk = extok[u.e * 65536 + pos]; o[h][i] = (unsigned)(tk >> 2) * (unsigned)PITCH + (unsigned)C0 * 2u; }
                else o[h][i] = (unsigned)((R0 + 64 * i + 128 * h) * PITCH + C0 * 2); }
    }
};

template <class E, class = void> struct UsesTab { static constexpr bool V = false; };
template <class E> struct UsesTab<E, decltype((void)E::USES_TAB)> { static constexpr bool V = E::USES_TAB; };
template <class E, class = void> struct AccBias { static constexpr bool V = false; };
template <class E> struct AccBias<E, decltype((void)E::ACC_BIAS)> { static constexpr bool V = E::ACC_BIAS; };
template <class Epi, class Sched>
__device__ __forceinline__ void gemm_phase(LAS unsigned char* lds, const Sched& S, const Epi& E, const int wid) {
    const int lane = fresh_lane(), tid = wid * 64 + lane, wr = wid >> 2, wc = wid & 3, fr = lane & 15, fq = lane >> 4;
    constexpr int PITCH = Sched::PITCH; constexpr bool FP8 = (PITCH == K); constexpr int nt = PITCH / 128;
    unsigned voffB[2]; int R0 = 0, C0 = 0;
#pragma unroll
    for (int i = 0; i < 2; ++i) { int R, C; stage_rc(tid * 16 + i * 8192, R, C); const int Rb = Epi::PERM ? ((R & ~31) + perm32(R & 31)) : R;
        voffB[i] = (unsigned)(Rb * PITCH + C * 2); if (i == 0) { R0 = R; C0 = C; } }
    const unsigned voffA0 = (unsigned)(R0 * PITCH + C0 * 2);
    const size_t kstep = (size_t)(BK * 2);
    const size_t hstep = (size_t)HALF * PITCH;
    const unsigned ldsw = (unsigned)wid * 1024u; const unsigned lbase_ = (unsigned)__builtin_amdgcn_readfirstlane((int)(unsigned)(__SIZE_TYPE__)lds);
    const int aoff = lds_byte(wr * 64 + fr, fq * 8), boff = lds_byte(wc * 32 + fr, fq * 8);
#define PG8_SA(b, h) (((b) * 2 + (h)) * HTB)
#define PG8_SB(b, h) ((4 + (b) * 2 + (h)) * HTB)
#define PG8_GLDS(gbase, voff, ldsaddr) do { unsigned keep_; const unsigned long long b_ = (unsigned long long)(gbase); \
        const unsigned long long bu_ = ((unsigned long long)(unsigned)__builtin_amdgcn_readfirstlane((int)(unsigned)(b_ >> 32)) << 32) | (unsigned)__builtin_amdgcn_readfirstlane((int)(unsigned)b_); \
        asm volatile("s_mov_b32 %0, m0\n\ts_mov_b32 m0, %2\n\ts_nop 0\n\tglobal_load_lds_dwordx4 %1, %3\n\ts_mov_b32 m0, %0" : "=&s"(keep_) : "v"(voff), "s"(ldsaddr), "s"(bu_) : "memory"); } while (0)
#define PG8_GLDS4(gbase, voff, ldsaddr) do { unsigned keep_; const unsigned long long b_ = (unsigned long long)(gbase); \
        const unsigned long long bu_ = ((unsigned long long)(unsigned)__builtin_amdgcn_readfirstlane((int)(unsigned)(b_ >> 32)) << 32) | (unsigned)__builtin_amdgcn_readfirstlane((int)(unsigned)b_); \
        asm volatile("s_mov_b32 %0, m0\n\ts_mov_b32 m0, %2\n\ts_nop 0\n\tglobal_load_lds_dword %1, %3\n\ts_mov_b32 m0, %0" : "=&s"(keep_) : "v"(voff), "s"(ldsaddr), "s"(bu_) : "memory"); } while (0)
#define PG8_STAGE2S(bufoff, gbase, o0) do { const unsigned la_ = lbase_ + (unsigned)(bufoff) + ldsw; \
        PG8_GLDS(gbase, o0, la_); PG8_GLDS((const char*)(gbase) + 64 * PITCH, o0, la_ + 8192u); } while (0)
#define PG8_STAGE2(bufoff, gbase, o0, o1) do { const unsigned la_ = lbase_ + (unsigned)(bufoff) + ldsw; \
        PG8_GLDS(gbase, o0, la_); PG8_GLDS(gbase, o1, la_ + 8192u); } while (0)
#define PG8_STAGE_B(bufoff, gbase) PG8_STAGE2S(bufoff, gbase, voffB[0])
#define PG8_STAGE_A(bufoff, gbase, off, h) do { if constexpr (Sched::GATHERS) PG8_STAGE2(bufoff, gbase, off[h][0], off[h][1]); \
        else PG8_STAGE2S(bufoff, (const char*)(gbase) + (h) * hstep, voffA0); } while (0)
#define PG8_LDA(dst, b, h) do { _Pragma("unroll") for (int m = 0; m < 4; ++m) { const v4i_t lo_ = *(const LAS v4i_t*)(lds + PG8_SA(b, h) + aoff + m * 2048), hi_ = *(const LAS v4i_t*)(lds + PG8_SA(b, h) + aoff + m * 2048 + 1024); \
        dst[m] = __builtin_shufflevector(lo_, hi_, 0, 1, 2, 3, 4, 5, 6, 7); } } while (0)
#define PG8_LDB(dst, b, h) do { _Pragma("unroll") for (int n = 0; n < 2; ++n) { const v4i_t lo_ = *(const LAS v4i_t*)(lds + PG8_SB(b, h) + boff + n * 2048), hi_ = *(const LAS v4i_t*)(lds + PG8_SB(b, h) + boff + n * 2048 + 1024); \
        dst[n] = __builtin_shufflevector(lo_, hi_, 0, 1, 2, 3, 4, 5, 6, 7); } } while (0)
#define PG8_LO(x) __builtin_bit_cast(bf16x8, __builtin_shufflevector(x, x, 0, 1, 2, 3))
#define PG8_HI(x) __builtin_bit_cast(bf16x8, __builtin_shufflevector(x, x, 4, 5, 6, 7))
#define PG8_MMA(ai, bj, At, Bt) do { __builtin_amdgcn_s_setprio(1); _Pragma("unroll") for (int m = 0; m < 4; ++m) _Pragma("unroll") for (int n = 0; n < 2; ++n) { \
        if constexpr (FP8) acc[ai][bj][m][n] = __builtin_amdgcn_mfma_scale_f32_16x16x128_f8f6f4(Bt[n], At[m], acc[ai][bj][m][n], 0, 0, 0, (int)Epi::SCALE_W, 0, (int)Epi::SCALE_A); \
        else { acc[ai][bj][m][n] = __builtin_amdgcn_mfma_f32_16x16x32_bf16(PG8_LO(Bt[n]), PG8_LO(At[m]), acc[ai][bj][m][n], 0, 0, 0); acc[ai][bj][m][n] = __builtin_amdgcn_mfma_f32_16x16x32_bf16(PG8_HI(Bt[n]), PG8_HI(At[m]), acc[ai][bj][m][n], 0, 0, 0); } } \
        __builtin_amdgcn_s_setprio(0); } while (0)
#define PG8_WAIT_V(n) asm volatile("s_waitcnt vmcnt(" #n ")" ::: "memory")
#define PG8_WAIT_L(n) asm volatile("s_waitcnt lgkmcnt(" #n ")" ::: "memory")
#define PG8_BAR __builtin_amdgcn_s_barrier()
#define PG8_SCHED __builtin_amdgcn_sched_barrier(0)
    Unit cur, nxt; int ui = 0;
    if (!S.next(0, cur)) return;
    unsigned gc[2][2], gn[2][2];
    if constexpr (Sched::GATHERS) S.a_offsets(cur, wid, gc);
    f32x4 acc[2][2][4][2];
#pragma unroll
    for (int a = 0; a < 2; ++a)
#pragma unroll
        for (int b = 0; b < 2; ++b)
#pragma unroll
            for (int m = 0; m < 4; ++m)
#pragma unroll
                for (int n = 0; n < 2; ++n) acc[a][b][m][n] = (f32x4){0.f, 0.f, 0.f, 0.f};
    if constexpr (AccBias<Epi>::V) E.acc_init(acc, cur, wc, fq);
    v8i_t At[4], B0[2], B1[2];
    const char* cA = S.aptr(cur); const char* cB = S.bptr(cur);
#define PG8_EPI_PREFETCH(U, PAR) do { if constexpr (Epi::HAS_PREFETCH) { const unsigned eb_ = lbase_ + (unsigned)(TAB_EPI - RING_OFF) + (unsigned)(PAR) * EP_BUF + (unsigned)(wid & 3) * 256u; \
        const unsigned lo_ = (unsigned)((wid & 3) * 64 + fresh_lane()) * 4u;     \
        if (wid < 4) { PG8_GLDS4(E.tk_base(U), lo_, eb_); PG8_GLDS4(E.gate_base(U), lo_, eb_ + 1024u); } \
        else PG8_GLDS4(E.bias_base(U), lo_, eb_ + 2048u); } } while (0)
    PG8_EPI_PREFETCH(cur, 0);
    PG8_STAGE_B(PG8_SB(0, 0), cB); PG8_STAGE_B(PG8_SB(0, 1), cB + hstep); PG8_STAGE_A(PG8_SA(0, 0), cA, gc, 0); PG8_STAGE_A(PG8_SA(0, 1), cA, gc, 1);
    if (wr == 1) PG8_BAR;
    PG8_WAIT_V(2); PG8_BAR;
    PG8_STAGE_B(PG8_SB(1, 0), cB + kstep); PG8_STAGE_A(PG8_SA(1, 0), cA + kstep, gc, 0); PG8_STAGE_B(PG8_SB(1, 1), cB + hstep + kstep);
    PG8_WAIT_V(6); PG8_BAR;
    for (;;) {
        const bool has_next = S.next(ui + 1, nxt);
        const char* nA = has_next ? S.aptr(nxt) : cA; const char* nB = has_next ? S.bptr(nxt) : cB;
        if constexpr (Sched::GATHERS) {
            if (has_next) S.a_offsets(nxt, wid, gn);
            else {
#pragma unroll
                for (int h = 0; h < 2; ++h)
#pragma unroll
                    for (int i = 0; i < 2; ++i) gn[h][i] = gc[h][i]; }
            *(LAS u32x4*)(lds + (TAB_GOFF - RING_OFF) + tid * 16) = (u32x4){gn[0][0], gn[0][1], gn[1][0], gn[1][1]}; }
#pragma unroll 1
        for (int t = 0; t < nt; t += 2) {
            const bool last = (t == nt - 2);
            const char* a1 = cA + (size_t)(t + 1) * kstep;
            const char* a2 = last ? nA : cA + (size_t)(t + 2) * kstep; const char* b2 = last ? nB : cB + (size_t)(t + 2) * kstep;
            const char* a3 = a2 + kstep; const char* b3 = b2 + kstep;
            unsigned o2[2][2];
            if constexpr (Sched::GATHERS) {
#pragma unroll
                for (int h = 0; h < 2; ++h)
#pragma unroll
                    for (int i = 0; i < 2; ++i) o2[h][i] = gc[h][i];
                if (last) { const u32x4 g_ = *(const LAS u32x4*)(lds + (TAB_GOFF - RING_OFF) + tid * 16); o2[0][0] = g_.x; o2[0][1] = g_.y; o2[1][0] = g_.z; o2[1][1] = g_.w; } }
            PG8_LDB(B0, 0, 0); PG8_LDB(B1, 0, 1); PG8_SCHED; PG8_LDA(At, 0, 0); PG8_STAGE_A(PG8_SA(1, 1), a1, gc, 1);
            PG8_WAIT_V(8); PG8_WAIT_L(0); PG8_BAR; PG8_MMA(0, 0, At, B0); PG8_MMA(0, 1, At, B1); PG8_BAR; PG8_SCHED;
            PG8_LDA(At, 0, 1); PG8_STAGE_B(PG8_SB(0, 0), b2); PG8_STAGE_B(PG8_SB(0, 1), b2 + hstep); PG8_STAGE_A(PG8_SA(0, 0), a2, o2, 0);
            PG8_WAIT_V(8); PG8_WAIT_L(0); PG8_BAR; PG8_MMA(1, 0, At, B0); PG8_MMA(1, 1, At, B1); PG8_BAR; PG8_SCHED;
            PG8_LDB(B0, 1, 0); PG8_LDB(B1, 1, 1); PG8_SCHED; PG8_LDA(At, 1, 0); PG8_STAGE_A(PG8_SA(0, 1), a2, o2, 1);
            PG8_WAIT_V(8); PG8_WAIT_L(0); PG8_BAR; PG8_MMA(0, 0, At, B0); PG8_MMA(0, 1, At, B1); PG8_BAR; PG8_SCHED;
            PG8_LDA(At, 1, 1); PG8_STAGE_B(PG8_SB(1, 0), b3); PG8_STAGE_B(PG8_SB(1, 1), b3 + hstep); PG8_STAGE_A(PG8_SA(1, 0), a3, o2, 0);
            PG8_WAIT_V(8); PG8_WAIT_L(0); PG8_BAR; PG8_MMA(1, 0, At, B0); PG8_MMA(1, 1, At, B1); PG8_BAR; PG8_SCHED;
        }
        if (wr == 0) PG8_BAR;
        { const int le_ = fresh_lane();
          if constexpr (AccBias<Epi>::V) E.run_acc(acc, cur, nxt, has_next, wr, wc, le_ & 15, le_ >> 4);
          else if constexpr (Epi::HAS_PREFETCH) E.run(acc, cur, wr, wc, le_ & 15, le_ >> 4, lds + (TAB_EPI - RING_OFF) + (ui & 1) * EP_BUF);
          else if constexpr (UsesTab<Epi>::V) E.run_tab(acc, cur, wr, wc, le_ & 15, le_ >> 4, lds + (TAB_EPI - RING_OFF)); else E(acc, cur, wr, wc, le_ & 15, le_ >> 4); }
        if (!has_next) break;
        if constexpr (!AccBias<Epi>::V) {
#pragma unroll
        for (int a = 0; a < 2; ++a)
#pragma unroll
            for (int b = 0; b < 2; ++b)
#pragma unroll
                for (int m = 0; m < 4; ++m)
#pragma unroll
                    for (int n = 0; n < 2; ++n) acc[a][b][m][n] = (f32x4){0.f, 0.f, 0.f, 0.f}; }
        cur = nxt; cA = nA; cB = nB; ++ui;
        PG8_EPI_PREFETCH(cur, ui & 1);
        if constexpr (Sched::GATHERS) { const u32x4 g_ = *(const LAS u32x4*)(lds + (TAB_GOFF - RING_OFF) + tid * 16); gc[0][0] = g_.x; gc[0][1] = g_.y; gc[1][0] = g_.z; gc[1][1] = g_.w; }
        if (wr == 1) PG8_BAR;
    }
    PG8_WAIT_V(0);
    PG8_BAR;
#undef PG8_SA
#undef PG8_SB
#undef PG8_STAGE2
#undef PG8_STAGE2S
#undef PG8_GLDS
#undef PG8_GLDS4
#undef PG8_STAGE_A
#undef PG8_EPI_PREFETCH
#undef PG8_STAGE_B
#undef PG8_LDA
#undef PG8_LDB
#undef PG8_MMA
#undef PG8_LO
#undef PG8_HI
#undef PG8_WAIT_V
#undef PG8_WAIT_L
#undef PG8_BAR
#undef PG8_SCHED
}

typedef float f32x2 __attribute__((ext_vector_type(2)));
#define PK2(V, I) ((f32x2){V[I], V[(I) + 1]})
struct EpiQKV {
    static constexpr bool PERM = true; static constexpr bool HAS_PREFETCH = false; static constexpr bool USES_TAB = true;
    __device__ __forceinline__ void operator()(const f32x4 (&)[2][2][4][2], const Unit&, int, int, int, int) const {} static constexpr unsigned SCALE_W = 0x7f7f7f7fu, SCALE_A = 0x7f7f7f7fu; const P* pp;
    __device__ __forceinline__ void run_tab(const f32x4 (&acc)[2][2][4][2], const Unit& u, int wr, int wc, int fr, int fq, const LAS unsigned char* ep) const {
        const P& p = *pp; const int hc = u.pn * 4 + wc; const int b = u.pm >> 4, tokb = (u.pm & 15) * 256 + wr * 64 + fr, lane = fq * 16 + fr;
        const LAS float* tab = (const LAS float*)ep; const float posf = (float)(tokb + NMETA);
        if (hc < 10) {
            const LAS float* g = tab + (hc < 8 ? 0 : 64); f32x4 gv[2][2];
#pragma unroll
            for (int bj = 0; bj < 2; ++bj)
#pragma unroll
                for (int n = 0; n < 2; ++n) gv[bj][n] = *(const LAS f32x4*)(g + 32 * bj + 8 * fq + 4 * n);
            f32x2 co[4], si[4], rc[4], rsn[4];
            { const LAS f32x4* rr = (const LAS f32x4*)(tab + 192 + 16 * fq); const LAS f32x4* iv = (const LAS f32x4*)(tab + 288 + 8 * fq);
#pragma unroll
              for (int q = 0; q < 4; ++q) { const f32x4 r4 = rr[q]; rc[q] = (f32x2){r4[0], r4[2]}; rsn[q] = (f32x2){r4[1], r4[3]}; }
#pragma unroll
              for (int q = 0; q < 2; ++q) { const f32x4 i4 = iv[q];
#pragma unroll
                  for (int j = 0; j < 4; ++j) { const float xr = __builtin_amdgcn_fractf(posf * i4[j]); co[2 * q + (j >> 1)][j & 1] = __builtin_amdgcn_cosf(xr); si[2 * q + (j >> 1)][j & 1] = __builtin_amdgcn_sinf(xr); } } }
            bf16_t* dst = hc < 8 ? (bf16_t*)(p.ws + WS_QA) + (size_t)(b * 8 + hc) * HEAD_EL : (bf16_t*)(p.ws + WS_KA) + (size_t)(b * 2 + (hc - 8)) * HEAD_EL;
            const float osc = hc < 8 ? QSCALE_A : 1.0f;
#pragma unroll
            for (int ai = 0; ai < 2; ++ai) {
                float rsv[4];
#pragma unroll
                for (int m = 0; m < 4; ++m) { f32x2 sq[2];
#pragma unroll
                    for (int bj = 0; bj < 2; ++bj) { const f32x4 x = acc[ai][bj][m][0], y = acc[ai][bj][m][1]; sq[bj] = PK2(x, 0) * PK2(x, 0); sq[bj] += PK2(x, 2) * PK2(x, 2); sq[bj] += PK2(y, 0) * PK2(y, 0); sq[bj] += PK2(y, 2) * PK2(y, 2); }
                    const f32x2 sq2 = sq[0] + sq[1];
                    const float ss = sum4rows(sq2[0] + sq2[1]);
                    rsv[m] = __builtin_amdgcn_rsqf(ss * (1.0f / 64.0f) + EPS) * osc; }
#pragma unroll
                for (int m = 0; m < 4; ++m) { const int tok = tokb + 128 * ai + 16 * m; const float rs = rsv[m];
                    float o0[8], o1[8];
#pragma unroll
                    for (int n = 0; n < 2; ++n) { const f32x4 y0 = acc[ai][0][m][n] * rs * gv[0][n], y1 = acc[ai][1][m][n] * rs * gv[1][n];
#pragma unroll
                        for (int j = 0; j < 4; j += 2) { const f32x2 c = co[2 * n + (j >> 1)], s_ = si[2 * n + (j >> 1)], a0 = PK2(y0, j), a1 = PK2(y1, j); const f32x2 r0 = a0 * c - a1 * s_, r1 = a1 * c + a0 * s_;
                            o0[4 * n + j] = r0[0]; o0[4 * n + j + 1] = r0[1]; o1[4 * n + j] = r1[0]; o1[4 * n + j + 1] = r1[1]; } }
                    u32x4 w0, w1; w0.x = cvt_pk_bf16(o0[0], o0[1]); w0.y = cvt_pk_bf16(o0[2], o0[3]); w0.z = cvt_pk_bf16(o0[4], o0[5]); w0.w = cvt_pk_bf16(o0[6], o0[7]);
                    w1.x = cvt_pk_bf16(o1[0], o1[1]); w1.y = cvt_pk_bf16(o1[2], o1[3]); w1.z = cvt_pk_bf16(o1[4], o1[5]); w1.w = cvt_pk_bf16(o1[6], o1[7]);
                    if (hc < 8) { bf16_t* q = dst + (size_t)tok * 64 + 8 * fq; *(u32x4*)q = w0; *(u32x4*)(q + 32) = w1; }
                    else { bf16_t* k = dst + (tok >> 6) * TILE_EL + (tok & 63) * 8 + fq * 512; *(u32x4*)k = w0; *(u32x4*)(k + 4 * 512) = w1; }
#pragma unroll
                    for (int i = 0; i < 4; ++i) { const f32x2 c2 = co[i] * rc[i] - si[i] * rsn[i], s2 = si[i] * rc[i] + co[i] * rsn[i]; co[i] = c2; si[i] = s2; } }
#pragma unroll
                for (int k4 = 0; k4 < 4; ++k4)
#pragma unroll
                    for (int i = 0; i < 4; ++i) { const f32x2 c2 = co[i] * rc[i] - si[i] * rsn[i], s2 = si[i] * rc[i] + co[i] * rsn[i]; co[i] = c2; si[i] = s2; } }
        } else if (hc < 12 || hc >= 28) {
            bf16_t* dst = hc < 12 ? (bf16_t*)(p.ws + WS_VA) + (size_t)(b * 2 + (hc - 10)) * HEAD_EL : (bf16_t*)(p.ws + WS_VB) + (size_t)(b * 8 + (hc - 28)) * HEAD_EL;
#pragma unroll
            for (int ai = 0; ai < 2; ++ai)
#pragma unroll
                for (int m = 0; m < 4; ++m) { const int tok = tokb + 128 * ai + 16 * m; bf16_t* v = dst + (tok >> 6) * TILE_EL + ((tok & 63) >> 4) * 512 + (tok & 15) * 32 + 8 * fq;
#pragma unroll
                    for (int bj = 0; bj < 2; ++bj) { const f32x4 x0 = acc[ai][bj][m][0], x1 = acc[ai][bj][m][1]; u32x4 w; w.x = cvt_pk_bf16(x0[0], x0[1]); w.y = cvt_pk_bf16(x0[2], x0[3]); w.z = cvt_pk_bf16(x1[0], x1[1]); w.w = cvt_pk_bf16(x1[2], x1[3]);
                        *(u32x4*)(v + bj * 2048) = w; } }
        } else {
            const bool isq = hc < 20; const LAS float* g = tab + (isq ? 128 : 160); f32x4 gv[2];
#pragma unroll
            for (int n = 0; n < 2; ++n) gv[n] = *(const LAS f32x4*)(g + 4 * fq + 16 * n);
            f32x2 co[2], si[2], rc[2], rsn[2];
            { const LAS f32x4* rr = (const LAS f32x4*)(tab + 256 + 8 * fq); const f32x4 i4 = *(const LAS f32x4*)(tab + 320 + 4 * fq);
#pragma unroll
              for (int q = 0; q < 2; ++q) { const f32x4 r4 = rr[q]; rc[q] = (f32x2){r4[0], r4[2]}; rsn[q] = (f32x2){r4[1], r4[3]}; }
#pragma unroll
              for (int j = 0; j < 4; ++j) { const float xr = __builtin_amdgcn_fractf(posf * i4[j]); co[j >> 1][j & 1] = __builtin_amdgcn_cosf(xr); si[j >> 1][j & 1] = __builtin_amdgcn_sinf(xr); } }
            bf16_t* dst = isq ? (bf16_t*)(p.ws + WS_QB) + (size_t)(b * 8 + (hc - 12)) * HEAD_EL : (bf16_t*)(p.ws + WS_KB) + (size_t)(b * 8 + (hc - 20)) * HEAD_EL;
            const float osc = isq ? QSCALE_B : 1.0f;
#pragma unroll
            for (int ai = 0; ai < 2; ++ai) {
                float rsv[4][2];
#pragma unroll
                for (int m = 0; m < 4; ++m)
#pragma unroll
                    for (int bj = 0; bj < 2; ++bj) { const f32x4 x0 = acc[ai][bj][m][0], x1 = acc[ai][bj][m][1];
                        f32x2 sqa = PK2(x0, 0) * PK2(x0, 0), sqb = PK2(x1, 0) * PK2(x1, 0); sqa += PK2(x0, 2) * PK2(x0, 2); sqb += PK2(x1, 2) * PK2(x1, 2); const f32x2 sq2 = sqa + sqb;
                        const float ss = sum4rows(sq2[0] + sq2[1]);
                        rsv[m][bj] = __builtin_amdgcn_rsqf(ss * (1.0f / 32.0f) + EPS) * osc; }
#pragma unroll
                for (int m = 0; m < 4; ++m) { const int tok = tokb + 128 * ai + 16 * m;
#pragma unroll
                    for (int bj = 0; bj < 2; ++bj) { const f32x4 x0 = acc[ai][bj][m][0], x1 = acc[ai][bj][m][1]; const float rs = rsv[m][bj];
                        const f32x4 y0 = x0 * rs * gv[0], y1 = x1 * rs * gv[1]; float o0[4], o1[4];
#pragma unroll
                        for (int j = 0; j < 4; j += 2) { const f32x2 c = co[j >> 1], s_ = si[j >> 1], a0 = PK2(y0, j), a1 = PK2(y1, j); const f32x2 r0 = a0 * c - a1 * s_, r1 = a1 * c + a0 * s_; o0[j] = r0[0]; o0[j + 1] = r0[1]; o1[j] = r1[0]; o1[j + 1] = r1[1]; }
                        u32x4 w; w.x = cvt_pk_bf16(o0[0], o0[1]); w.y = cvt_pk_bf16(o0[2], o0[3]); w.z = cvt_pk_bf16(o1[0], o1[1]); w.w = cvt_pk_bf16(o1[2], o1[3]);
                        if (isq) *(u32x4*)(dst + (size_t)tok * 64 + 32 * bj + 8 * fq) = w;
                        else *(u32x4*)(dst + (tok >> 6) * TILE_EL + (tok & 63) * 8 + (4 * bj + fq) * 512) = w; }
#pragma unroll
                    for (int i = 0; i < 2; ++i) { const f32x2 c2 = co[i] * rc[i] - si[i] * rsn[i], s2 = si[i] * rc[i] + co[i] * rsn[i]; co[i] = c2; si[i] = s2; } }
#pragma unroll
                for (int k4 = 0; k4 < 4; ++k4)
#pragma unroll
                    for (int i = 0; i < 2; ++i) { const f32x2 c2 = co[i] * rc[i] - si[i] * rsn[i], s2 = si[i] * rc[i] + co[i] * rsn[i]; co[i] = c2; si[i] = s2; } }
        }
    }
};
struct EpiO {
    static constexpr bool PERM = true; static constexpr bool HAS_PREFETCH = false; static constexpr unsigned SCALE_W = 0x7f7f7f7fu, SCALE_A = 0x7f7f7f7fu; bf16_t* ob;
    __device__ __forceinline__ void operator()(const f32x4 (&acc)[2][2][4][2], const Unit& u, int wr, int wc, int fr, int fq) const {
        const int row0 = u.pm * BM + wr * 64 + fr, col0 = u.pn * BM + wc * 32 + 8 * fq;
#pragma unroll
        for (int ai = 0; ai < 2; ++ai)
#pragma unroll
            for (int m = 0; m < 4; ++m) { bf16_t* rowp = ob + (size_t)(row0 + ai * HALF + m * 16) * 2048 + col0;
#pragma unroll
                for (int bj = 0; bj < 2; ++bj) { const f32x4 v0 = acc[ai][bj][m][0], v1 = acc[ai][bj][m][1]; u32x4 w; w.x = cvt_pk_bf16(v0[0], v0[1]); w.y = cvt_pk_bf16(v0[2], v0[3]); w.z = cvt_pk_bf16(v1[0], v1[1]); w.w = cvt_pk_bf16(v1[2], v1[3]);
                    *(u32x4*)(rowp + bj * HALF) = w; } }
    }
};
__device__ __forceinline__ float cl448f(float v) { return fminf(fmaxf(v, -448.0f), 448.0f); }
__device__ __forceinline__ unsigned pk4_fp8(float a, float b, float c, float d) { int r; asm("" : "=v"(r));
    r = __builtin_amdgcn_cvt_pk_fp8_f32(a, b, r, false); r = __builtin_amdgcn_cvt_pk_fp8_f32(c, d, r, true); return (unsigned)r; }
struct EpiSwiglu {
    static constexpr bool PERM = true; static constexpr bool HAS_PREFETCH = false; static constexpr unsigned SCALE_W = 0x7c7c7c7cu, SCALE_A = 0x7c7c7c7cu  ; const float* b1; unsigned char* act;
    static constexpr bool ACC_BIAS = true;
    __device__ __forceinline__ void operator()(const f32x4 (&)[2][2][4][2], const Unit&, int, int, int, int) const {}
    __device__ __forceinline__ const float* bias_ptr(const Unit& u, int wc, int fq) const { return b1 + (size_t)u.e * 2048 + u.pn * 128 + wc * 32 + 8 * fq; }
    __device__ __forceinline__ void acc_init(f32x4 (&acc)[2][2][4][2], const Unit& u, int wc, int fq) const {
        const float* bg = bias_ptr(u, wc, fq);
#pragma unroll
        for (int n = 0; n < 2; ++n) { acc[0][0][0][n] = *(const f32x4*)(bg + 4 * n); acc[0][1][0][n] = *(const f32x4*)(bg + 1024 + 4 * n); }
#pragma unroll
        for (int a = 0; a < 2; ++a)
#pragma unroll
            for (int m = 0; m < 4; ++m)
#pragma unroll
                for (int n = 0; n < 2; ++n) { if (a + m) { acc[a][0][m][n] = acc[0][0][0][n]; acc[a][1][m][n] = acc[0][1][0][n]; } asm volatile("" : "+v"(acc[a][0][m][n]), "+v"(acc[a][1][m][n])); }
    }
    __device__ __forceinline__ void run_acc(f32x4 (&acc)[2][2][4][2], const Unit& u, const Unit& nx, bool has_next, int wr, int wc, int fr, int fq) const {
        float c7; asm volatile("v_mov_b32 %0, 0x40e00000" : "=v"(c7));
#pragma unroll
        for (int ai = 0; ai < 2; ++ai)
#pragma unroll
            for (int mp = 0; mp < 4; mp += 2) { u32x2 w[2];
#pragma unroll
                for (int q = 0; q < 2; ++q) { const int m = mp + q; float a[8];
#pragma unroll
                    for (int n = 0; n < 2; ++n) { const f32x4 gl = acc[ai][0][m][n], li = acc[ai][1][m][n];
#pragma unroll
                        for (int j = 0; j < 4; j += 2) {
                            float g0_, g1_; asm("v_min_f32 %0, %1, %2" : "=v"(g0_) : "v"(gl[j]), "v"(c7)); asm("v_min_f32 %0, %1, %2" : "=v"(g1_) : "v"(gl[j + 1]), "v"(c7));
                            const f32x2 g2 = {g0_, g1_}, l2 = {__builtin_amdgcn_fmed3f(li[j], -c7, c7), __builtin_amdgcn_fmed3f(li[j + 1], -c7, c7)};
                            const f32x2 t2 = g2 * (-1.702f * LOG2E); const f32x2 e2 = {__builtin_amdgcn_exp2f(t2[0]), __builtin_amdgcn_exp2f(t2[1])}; const f32x2 d2 = e2 + 1.0f;
                            const f32x2 r2 = {__builtin_amdgcn_rcpf(d2[0]), __builtin_amdgcn_rcpf(d2[1])}; const f32x2 o2 = (g2 * r2) * (l2 * 8.0f + 8.0f);
                            a[4 * n + j] = o2[0]; a[4 * n + j + 1] = o2[1]; } }
                    w[q].x = pk4_fp8(a[0], a[1], a[2], a[3]); w[q].y = pk4_fp8(a[4], a[5], a[6], a[7]); }
                const auto sx = __builtin_amdgcn_permlane16_swap(w[0].x, w[1].x, false, false), sy = __builtin_amdgcn_permlane16_swap(w[0].y, w[1].y, false, false);
                const unsigned row = (unsigned)(u.pm * BM + ai * HALF + wr * 64 + (mp + (fq & 1)) * 16 + fr);
                *(u32x4*)(act + (row * (unsigned)DM + (unsigned)(u.pn * 128 + wc * 32 + 16 * (fq >> 1)))) = (u32x4){sx[0], sy[0], sx[1], sy[1]};
                if (has_next && ai == 0 && mp == 0) { const float* bg = bias_ptr(nx, wc, fq);
#pragma unroll
                    for (int n = 0; n < 2; ++n) { acc[0][0][0][n] = *(const f32x4*)(bg + 4 * n); acc[0][1][0][n] = *(const f32x4*)(bg + 1024 + 4 * n); } } }
        if (has_next) {
#pragma unroll
            for (int a = 0; a < 2; ++a)
#pragma unroll
                for (int m = 0; m < 4; ++m)
#pragma unroll
                    for (int n = 0; n < 2; ++n) if (a + m) { acc[a][0][m][n] = acc[0][0][0][n]; acc[a][1][m][n] = acc[0][1][0][n]; } }
    }
    __device__ __forceinline__ void run(const f32x4 (&)[2][2][4][2], const Unit&, int, int, int, int, const LAS unsigned char*) const {}
    __device__ __forceinline__ const char* tk_base(const Unit&) const { return nullptr; }
    __device__ __forceinline__ const char* gate_base(const Unit&) const { return nullptr; }
    __device__ __forceinline__ const char* bias_base(const Unit&) const { return nullptr; }
};
struct EpiMoe2 {
    static constexpr bool PERM = true; static constexpr bool HAS_PREFETCH = true; static constexpr unsigned SCALE_W = 0x7c7c7c7cu, SCALE_A = 0x7c7c7c7cu  ;
    const float* b2; const int* extok; const float* exgate; unsigned char* ob; unsigned char* ys3;
    __device__ __forceinline__ const char* tk_base(const Unit& u) const { return (const char*)(extok + (size_t)u.e * 65536 + u.pos0); }
    __device__ __forceinline__ const char* gate_base(const Unit& u) const { return (const char*)(exgate + (size_t)u.e * 65536 + u.pos0); }
    __device__ __forceinline__ const char* bias_base(const Unit& u) const { return (const char*)(b2 + (size_t)u.e * DM + u.pn * BM); }
    __device__ __forceinline__ void operator()(const f32x4 (&)[2][2][4][2], const Unit&, int, int, int, int) const {}
    __device__ __forceinline__ void run(const f32x4 (&acc)[2][2][4][2], const Unit& u, int wr, int wc, int fr, int fq, const LAS unsigned char* ep) const {
        const int col = u.pn * BM + wc * 64 + 16 * fq; const LAS int* ltk = (const LAS int*)ep; const LAS float* lgt = (const LAS float*)(ep + 1024); const LAS float* lb = (const LAS float*)(ep + 2048) + wc * 64 + 16 * fq;
        f32x4 bv[2][2];
#pragma unroll
        for (int bj = 0; bj < 2; ++bj)
#pragma unroll
            for (int n = 0; n < 2; ++n) bv[bj][n] = *(const LAS f32x4*)(lb + 8 * bj + 4 * n);
#pragma unroll
        for (int ai = 0; ai < 2; ++ai)
#pragma unroll
            for (int m = 0; m < 4; ++m) { const int r = ai * HALF + wr * 64 + m * 16 + fr; const int tk = ltk[r]; const float gate = lgt[r];
                if (u.pos0 + r < u.cnt) { const int tok = tk >> 2, k = tk & 3;
                    const float g64 = gate * 64.0f; u32x4 w;
#pragma unroll
                    for (int bj = 0; bj < 2; ++bj) { const f32x4 v0 = (acc[ai][bj][m][0] + bv[bj][0]) * g64, v1 = (acc[ai][bj][m][1] + bv[bj][1]) * g64;
                        w[2 * bj] = pk4_fp8(cl448f(v0[0]), cl448f(v0[1]), cl448f(v0[2]), cl448f(v0[3])); w[2 * bj + 1] = pk4_fp8(cl448f(v1[0]), cl448f(v1[1]), cl448f(v1[2]), cl448f(v1[3])); }
                    if (k == 0) { const unsigned off = (unsigned)tok * 4096u + 2048u + (unsigned)col; *(u32x4*)(ob + off) = w; }
                    else { const unsigned off = ((unsigned)tok * 3u + (unsigned)(k - 1)) * (unsigned)DM + (unsigned)col; *(u32x4*)(ys3 + off) = w; } } }
    }
};
template <bool PERM_> struct EpiNull { static constexpr bool PERM = PERM_; static constexpr bool HAS_PREFETCH = false; static constexpr unsigned SCALE_W = 0x7f7f7f7fu, SCALE_A = 0x7f7f7f7fu;
    __device__ __forceinline__ void operator()(const f32x4 (&acc)[2][2][4][2], const Unit&, int, int, int, int) const {
#pragma unroll
        for (int a = 0; a < 2; ++a)
#pragma unroll
            for (int b = 0; b < 2; ++b)
#pragma unroll
                for (int m = 0; m < 4; ++m)
#pragma unroll
                    for (int n = 0; n < 2; ++n) asm volatile("" :: "v"(acc[a][b][m][n])); } };
}

#define RLX_AGENT __ATOMIC_RELAXED, __HIP_MEMORY_SCOPE_AGENT
#define LDS_WAIT() asm volatile("s_waitcnt lgkmcnt(0)" ::: "memory")
#define VM_WAIT() asm volatile("s_waitcnt vmcnt(0)" ::: "memory")
#define XB_TMO      128
#define XB_XCNT(j)  (256  + 64 * (j))
#define XB_XSUB(j)  (1280 + 64 * (j))
#define XB_XGEN(j)  (2304 + 64 * (j))
#define XB_TOP      3328
#define XB_TOPGEN   3392
#define XCD_BAR_WORDS 3456
#define XB_SPIN_CAP (1u << 18)

__device__ __forceinline__ unsigned xb_ld(unsigned* p)              { return __hip_atomic_load(p, __ATOMIC_RELAXED, __HIP_MEMORY_SCOPE_AGENT); }
__device__ __forceinline__ unsigned xb_add(unsigned* p, unsigned v) { return __hip_atomic_fetch_add(p, v, __ATOMIC_RELAXED, __HIP_MEMORY_SCOPE_AGENT); }
__device__ __forceinline__ unsigned xb_xcc_id() { return (unsigned)__builtin_amdgcn_s_getreg((3 << 11) | 20) & 0xFu; }
#define XB_SPIN(cond, bar) do { unsigned _sp = 0; while (cond) { __builtin_amdgcn_s_sleep(1); \
    if ((++_sp & 255u) == 0u) { if (xb_ld(&(bar)[XB_TMO])) break; if (_sp > XB_SPIN_CAP) { atomicAdd(&(bar)[XB_TMO], 1u); break; } } } } while (0)

struct XcdBarrier {
    unsigned* bar; unsigned x; int wave;
    volatile LAS unsigned* st;
};

__device__ __forceinline__ XcdBarrier xcd_barrier_post(unsigned* bar, volatile LAS unsigned* st, int wave) {
    XcdBarrier b; b.bar = bar; b.x = xb_xcc_id(); b.st = st; b.wave = wave;
    if (wave == 0 && fresh_lane() == 0) (void)xb_add(&bar[XB_XCNT(b.x)], 1u);
    return b;
}
__device__ __forceinline__ void xcd_barrier_complete(unsigned* bar, unsigned x, unsigned& nloc, unsigned& nx) {
    const unsigned G = gridDim.x * gridDim.y * gridDim.z;
    unsigned sum, cnt, mine, sp = 0u;
    for (;;) {
        sum = 0u; cnt = 0u; mine = 0u;
#pragma unroll
        for (unsigned j = 0; j < 16; ++j) { const unsigned c = xb_ld(&bar[XB_XCNT(j)]); sum += c; cnt += (c > 0u) ? 1u : 0u; mine = (j == x) ? c : mine; }
        if (sum == G) break;
        __builtin_amdgcn_s_sleep(1);
        if ((++sp & 255u) == 0u) { if (xb_ld(&bar[XB_TMO])) break; if (sp > XB_SPIN_CAP) { atomicAdd(&bar[XB_TMO], 1u); break; } }
    }
    nloc = mine > 0u ? mine : 1u; nx = cnt > 0u ? cnt : 1u;
}

__device__ __forceinline__ void xcd_barrier(const XcdBarrier& b) {
    asm volatile("s_waitcnt vmcnt(0)" ::: "memory");
    __syncthreads();
    if (b.wave == 0 && fresh_lane() == 0) {
        unsigned* bar = b.bar;
        __builtin_amdgcn_s_waitcnt(0);
        unsigned nloc = b.st[0], nx = b.st[1];
        if (nloc == 0u) { xcd_barrier_complete(bar, b.x, nloc, nx); b.st[0] = nloc; b.st[1] = nx; }
        const unsigned old = xb_add(&bar[XB_XSUB(b.x)], 1u);
        const unsigned gen = old / nloc;
        if (old + 1u == (gen + 1u) * nloc) {
            __builtin_amdgcn_fence(__ATOMIC_RELEASE, "agent");
            asm volatile("s_waitcnt vmcnt(0)" ::: "memory");
            const unsigned og = xb_add(&bar[XB_TOP], 1u);
            const unsigned tg = og / nx;
            if (og + 1u == (tg + 1u) * nx) xb_add(&bar[XB_TOPGEN], 1u);
            else XB_SPIN(xb_ld(&bar[XB_TOPGEN]) == tg, bar);
            __builtin_amdgcn_fence(__ATOMIC_ACQUIRE, "agent");
            xb_add(&bar[XB_XGEN(b.x)], 1u);
            asm volatile("s_waitcnt vmcnt(0)" ::: "memory");
        } else {
            XB_SPIN(xb_ld(&bar[XB_XGEN(b.x)]) == gen, bar);
            __builtin_amdgcn_fence(__ATOMIC_ACQUIRE, "agent");
            asm volatile("s_waitcnt vmcnt(0)" ::: "memory");
        }
    }
    __syncthreads();
}


__device__ __forceinline__ unsigned pk2(float lo, float hi) { return (unsigned)f2bf(lo) | ((unsigned)f2bf(hi) << 16); }
__device__ __forceinline__ int rmap_win(int c) { const int hc = c >> 6, d = c & 63, pn = hc >> 2, wc = hc & 3, bj = d >> 5, dd = d & 31; const int i = (hc >= 12 && hc < 28) ? bslot(dd) : dd; return 256 * pn + 128 * bj + 32 * wc + i; }
__device__ __forceinline__ int rmap_w1(int c) { const int bj = c >> 10, cc = c & 1023; return 256 * (cc >> 7) + 128 * bj + (cc & 127); }
__device__ __forceinline__ int rmap_w2(int c) { const int cc = c & 255; return (c & ~255) + 128 * ((cc >> 3) & 1) + 32 * (cc >> 6) + 8 * ((cc >> 4) & 3) + (cc & 7); }
template <int MAP> __device__ __forceinline__ void p0_transpose_item(const float* W, int N, bf16_t* WT, LAS float* scr, int item, int lane) {
    const int nblk = N / 32, kb = item / nblk, nb = item % nblk, k0 = 64 * kb, n0 = 32 * nb;
#pragma unroll 8
    for (int i = 0; i < 32; ++i) { const int kk = 2 * i + (lane >> 5); scr[kk * 33 + (lane & 31)] = W[(size_t)(k0 + kk) * N + n0 + (lane & 31)]; }
    LDS_WAIT(); asm volatile("" ::: "memory");
    const int c = lane & 7;
#pragma unroll
    for (int j = 0; j < 4; ++j) { const int n = (lane >> 3) + 8 * j; const LAS float* s = scr + (8 * c) * 33 + n;
        u32x4 o; o.x = pk2(s[0 * 33], s[1 * 33]); o.y = pk2(s[2 * 33], s[3 * 33]); o.z = pk2(s[4 * 33], s[5 * 33]); o.w = pk2(s[6 * 33], s[7 * 33]);
        const int src = n0 + n; const int row = MAP == 1 ? rmap_win(src) : MAP == 2 ? rmap_w1(src) : src;
        *(u32x4*)(WT + (size_t)row * DM + k0 + 8 * c) = o; }
    LDS_WAIT(); asm volatile("" ::: "memory");
}
__device__ __forceinline__ float cl448(float v) { return fminf(fmaxf(v, -448.0f), 448.0f); }
struct F8Item { const float* W; unsigned char* WT; int N, k0, n0, map; };
__device__ __forceinline__ F8Item f8_item(const P& p, int r) {
    constexpr int I_W1 = 8 * 64, I_W2 = 8 * 32; F8Item it;
    if (r < NE * I_W1) { const int e = r / I_W1, q = r % I_W1; it.W = p.w1 + (size_t)e * DM * 2048; it.WT = p.ws + WS_W1T + (size_t)e * 2048 * DM; it.N = 2048; it.k0 = 128 * (q / 64); it.n0 = 32 * (q % 64); it.map = 1; }
    else { r -= NE * I_W1; const int e = r / I_W2, q = r % I_W2; it.W = p.w2 + (size_t)e * DM * DM; it.WT = p.ws + WS_W2T + (size_t)e * DM * DM; it.N = DM; it.k0 = 128 * (q / 32); it.n0 = 32 * (q % 32); it.map = 0; }
    return it;
}
__device__ __forceinline__ void f8_load(const F8Item& it, f32x4 (&v)[16], int lane) {
#pragma unroll
    for (int i = 0; i < 16; ++i) v[i] = *(const f32x4*)(it.W + (size_t)(it.k0 + 32 * (i >> 2) + 4 * (lane >> 3) + (i & 3)) * it.N + it.n0 + 4 * (lane & 7));
}
__device__ __forceinline__ void f8_pack(const f32x4 (&v)[16], LAS float* scr, int lane) {
    LAS unsigned* su = (LAS unsigned*)scr; const int nq = lane & 7, kg = lane >> 3;
#pragma unroll
    for (int i2 = 0; i2 < 4; ++i2)
#pragma unroll
        for (int x = 0; x < 4; ++x) { const int r = 4 * nq + x, chunk = 2 * i2 + (kg >> 2);
            su[r * 32 + ((chunk ^ (r & 7)) << 2) + (kg & 3)] = pg8::pk4_fp8(cl448(8.0f * v[4 * i2][x]), cl448(8.0f * v[4 * i2 + 1][x]), cl448(8.0f * v[4 * i2 + 2][x]), cl448(8.0f * v[4 * i2 + 3][x])); }
    LDS_WAIT(); asm volatile("" ::: "memory");
}
__device__ __forceinline__ void f8_store(const F8Item& it, LAS float* scr, int lane) {
    const LAS unsigned* su = (const LAS unsigned*)scr; const int n = lane >> 1, half = lane & 1;
    u32x4 o[4];
#pragma unroll
    for (int q = 0; q < 4; ++q) o[q] = *(const LAS u32x4*)(su + n * 32 + (((4 * half + q) ^ (n & 7)) << 2));
    const int src = it.n0 + n; const int row = it.map ? rmap_w1(src) : rmap_w2(src); unsigned char* dst = it.WT + (size_t)row * DM + it.k0 + 64 * half;
#pragma unroll
    for (int q = 0; q < 4; ++q) *(u32x4*)(dst + 16 * q) = o[q];
    LDS_WAIT(); asm volatile("" ::: "memory");
}
__device__ __forceinline__ void f8_share(const P& p, LAS unsigned char* ring, int G, int vcu, int wave) {
    const int lane = fresh_lane(); LAS float* scr = (LAS float*)(ring + wave * 16384);
    const int gw = vcu * NWAVES + wave, NGW = G * NWAVES; constexpr int NF8 = NE * (8 * 64 + 8 * 32);
    f32x4 va[16], vb[16]; int it = gw;
    F8Item ia = f8_item(p, it < NF8 ? it : 0), ib = ia;
    if (it < NF8) f8_load(ia, va, lane);
    if (it + NGW < NF8) { ib = f8_item(p, it + NGW); f8_load(ib, vb, lane); }
    while (it < NF8) {
        { const F8Item cur = ia; f8_pack(va, scr, lane); if (it + 2 * NGW < NF8) { ia = f8_item(p, it + 2 * NGW); f8_load(ia, va, lane); } f8_store(cur, scr, lane); }
        if (it + NGW >= NF8) break;
        { const F8Item cur = ib; f8_pack(vb, scr, lane); if (it + 3 * NGW < NF8) { ib = f8_item(p, it + 3 * NGW); f8_load(ib, vb, lane); } f8_store(cur, scr, lane); }
        it += 2 * NGW;
    }
}


namespace att {
typedef float f32x16 __attribute__((ext_vector_type(16)));
typedef short s16x4 __attribute__((ext_vector_type(4)));
typedef short v4i16_t __attribute__((ext_vector_type(4)));
constexpr int SLOTB = 16384, NSLOT = 3, STG_OFF = NSLOT * SLOTB, STG_W = 8704, WS_OFF = 8 * STG_W + STG_OFF;
constexpr int GDH_OFF = WS_OFF + 8 * 256, ATT_LDS = GDH_OFF + 256;
static_assert(ATT_LDS <= RING_BYTES, "attention LDS");
__device__ __forceinline__ int crow(int r, int hi) { return (r & 3) + 8 * (r >> 2) + 4 * hi; }
__device__ __forceinline__ unsigned cvtpk(float lo, float hi) { unsigned r; asm volatile("v_cvt_pk_bf16_f32 %0, %1, %2" : "=v"(r) : "v"(lo), "v"(hi)); return r; }
__device__ __forceinline__ s16x4 vtr(const LAS unsigned char* p) { return __builtin_bit_cast(s16x4, __builtin_amdgcn_ds_read_tr16_b64_v4i16((LAS v4i16_t*)p)); }
#define ATT_WAITV(n) asm volatile("s_waitcnt vmcnt(" #n ")" ::: "memory")
#define ATT_BAR() do { asm volatile("s_waitcnt lgkmcnt(0)" ::: "memory"); __builtin_amdgcn_s_barrier(); asm volatile("" ::: "memory"); } while (0)

template <int D0, int ND, bool HALF1> __device__ __forceinline__ void qk(f32x16& p0, f32x16& p1, const LAS unsigned char* kb, const bf16x8 (&qr)[4]) {
    const f32x16 z = {0.f, 0.f, 0.f, 0.f, 0.f, 0.f, 0.f, 0.f, 0.f, 0.f, 0.f, 0.f, 0.f, 0.f, 0.f, 0.f};
#pragma unroll
    for (int d = 0; d < ND; ++d) {
        const bf16x8 k0 = *(const LAS bf16x8*)(kb + (D0 + d) * 2048);
        p0 = __builtin_amdgcn_mfma_f32_32x32x16_bf16(k0, qr[D0 + d], d == 0 ? z : p0, 0, 0, 0);
        if (HALF1) { const bf16x8 k1 = *(const LAS bf16x8*)(kb + (D0 + d) * 2048 + 512); p1 = __builtin_amdgcn_mfma_f32_32x32x16_bf16(k1, qr[D0 + d], d == 0 ? z : p1, 0, 0, 0); }
    }
}
__device__ __forceinline__ void softpack(f32x16& s, float& l, u32x4& w0, u32x4& w1) {
#pragma unroll
    for (int r = 0; r < 16; ++r) s[r] = __builtin_amdgcn_exp2f(s[r]);
    float a = (s[0] + s[1]) + (s[2] + s[3]), b = (s[4] + s[5]) + (s[6] + s[7]), c = (s[8] + s[9]) + (s[10] + s[11]), d = (s[12] + s[13]) + (s[14] + s[15]);
    l += (a + b) + (c + d);
    w0.x = cvtpk(s[0], s[1]); w0.y = cvtpk(s[2], s[3]); w0.z = cvtpk(s[4], s[5]); w0.w = cvtpk(s[6], s[7]);
    w1.x = cvtpk(s[8], s[9]); w1.y = cvtpk(s[10], s[11]); w1.z = cvtpk(s[12], s[13]); w1.w = cvtpk(s[14], s[15]);
}
#define ATT_TR(dst, addr, OFF) asm volatile("ds_read_b64_tr_b16 %0, %1 offset:%c2" : "=&v"(dst) : "v"(addr), "i"(OFF) : "memory")
#define ATT_LGKM0() do { asm volatile("s_waitcnt lgkmcnt(0)" ::: "memory"); __builtin_amdgcn_sched_barrier(0); } while (0)
#define ATT_VF(lo, hi) (bf16x8){lo[0], lo[1], lo[2], lo[3], hi[0], hi[1], hi[2], hi[3]}

struct Src { const bf16_t* q; const bf16_t* k; const bf16_t* v; const bf16_t* km; const bf16_t* vm; int t0, ntr; };

template <bool DIFF> __device__ __forceinline__ void unit(const P& p, LAS unsigned char* lds, const Src& S, int qa  , float lam, float sinkp, bf16_t* orow  , const int wid,
                                                     bf16x8 (&qr)[4], const bool pre  , const bool pn  , const Src& Sn) {
    const int lane = fresh_lane(), tid = wid * 64 + lane, r32 = lane & 31, hi = lane >> 5;
    const int NT = S.ntr + 1;
#define ATT_DMA_S(SS, j, slot) do { const bf16_t* ks_ = (j) < SS.ntr ? SS.k + (size_t)(SS.t0 + (j)) * TILE_EL : SS.km; const bf16_t* vs_ = (j) < SS.ntr ? SS.v + (size_t)(SS.t0 + (j)) * TILE_EL : SS.vm; \
        __builtin_amdgcn_global_load_lds((const unsigned*)(ks_ + tid * 8), (LAS unsigned*)(lds + (slot) + wid * 1024), 16, 0, 0); \
        __builtin_amdgcn_global_load_lds((const unsigned*)(vs_ + tid * 8), (LAS unsigned*)(lds + (slot) + 8192 + wid * 1024), 16, 0, 0); } while (0)
#define ATT_DMA(j, slot) ATT_DMA_S(S, j, slot)
    if (!pre) {
#pragma unroll
        for (int d0 = 0; d0 < 4; ++d0) qr[d0] = *(const bf16x8*)(S.q + (size_t)r32 * 64 + d0 * 16 + hi * 8);
        ATT_DMA(0, 0); ATT_DMA(1, SLOTB); }
    f32x16 o1[2], o2[2];
#pragma unroll
    for (int d = 0; d < 2; ++d)
#pragma unroll
        for (int r = 0; r < 16; ++r) { o1[d][r] = 0.f; o2[d][r] = 0.f; }
    float l1 = 0.f, l2 = 0.f;
    int sl_cur = 0, sl_n1 = SLOTB, sl_n2 = 2 * SLOTB;
    const int koff = hi * 1024 + r32 * 16;
    const int voff = 8192 + ((lane >> 4) & 1) * 32 + (lane & 3) * 8 + (4 * hi + ((lane & 15) >> 2)) * 64;
    for (int j = 0; j < NT; ++j) {
        if (j + 1 < NT) ATT_WAITV(2); else ATT_WAITV(0);
        ATT_BAR();
        if (j + 2 < NT) ATT_DMA(j + 2, sl_n2);
        const LAS unsigned char* kb = lds + sl_cur + koff; const unsigned vpa = (unsigned)(__SIZE_TYPE__)(lds + sl_cur + voff);
        if (j < S.ntr) {
            bool act = true, full = true;
            if (!DIFF) { const int kt = 64 * (S.t0 + j); act = (kt + 63 >= qa - 128) && (kt <= qa + 31 + 128); full = (qa + 31 - kt <= 128) && (kt + 63 - qa <= 128); }
            if (act) {
                f32x16 sa0, sa1, sb0, sb1; u32x4 wa[4], wb[4];
                if (DIFF) { qk<0, 2, true>(sa0, sa1, kb, qr); qk<2, 2, true>(sb0, sb1, kb, qr); }
                else { qk<0, 4, true>(sa0, sa1, kb, qr);
                    if (!full) { const int q = qa + r32, kt = 64 * (S.t0 + j) + 4 * hi;
#pragma unroll
                        for (int r = 0; r < 16; ++r) { const int kv = kt + (r & 3) + 8 * (r >> 2); const int d0 = q - kv, d1 = q - kv - 32;
                            if (d0 > 128 || d0 < -128) sa0[r] = -INFINITY; if (d1 > 128 || d1 < -128) sa1[r] = -INFINITY; } } }
                softpack(sa0, l1, wa[0], wa[1]); softpack(sa1, l1, wa[2], wa[3]);
                if (DIFF) { softpack(sb0, l2, wb[0], wb[1]); softpack(sb1, l2, wb[2], wb[3]); }
#pragma unroll
                for (int d0 = 0; d0 < 2; ++d0) {
                    s16x4 vl[4], vh[4];
                    ATT_TR(vl[0], vpa, d0 * 4096); ATT_TR(vh[0], vpa, d0 * 4096 + 512); ATT_TR(vl[1], vpa, d0 * 4096 + 1024); ATT_TR(vh[1], vpa, d0 * 4096 + 1024 + 512);
                    ATT_TR(vl[2], vpa, d0 * 4096 + 2048); ATT_TR(vh[2], vpa, d0 * 4096 + 2048 + 512); ATT_TR(vl[3], vpa, d0 * 4096 + 3072); ATT_TR(vh[3], vpa, d0 * 4096 + 3072 + 512);
                    ATT_LGKM0();
#pragma unroll
                    for (int ks = 0; ks < 4; ++ks) { const bf16x8 vf = ATT_VF(vl[ks], vh[ks]); o1[d0] = __builtin_amdgcn_mfma_f32_32x32x16_bf16(__builtin_bit_cast(bf16x8, wa[ks]), vf, o1[d0], 0, 0, 0);
                        if (DIFF) o2[d0] = __builtin_amdgcn_mfma_f32_32x32x16_bf16(__builtin_bit_cast(bf16x8, wb[ks]), vf, o2[d0], 0, 0, 0); }
                }
            }
        } else {
            f32x16 sa0, sa1, sb0, sb1; u32x4 wa0, wb0;
            if (DIFF) { qk<0, 2, false>(sa0, sa1, kb, qr); qk<2, 2, false>(sb0, sb1, kb, qr); } else qk<0, 4, false>(sa0, sa1, kb, qr);
            { float e[8];
#pragma unroll
              for (int r = 0; r < 8; ++r) { e[r] = __builtin_amdgcn_exp2f(sa0[r]); }
              l1 += ((e[0] + e[1]) + (e[2] + e[3])) + ((e[4] + e[5]) + (e[6] + e[7]));
              wa0.x = cvtpk(e[0], e[1]); wa0.y = cvtpk(e[2], e[3]); wa0.z = cvtpk(e[4], e[5]); wa0.w = cvtpk(e[6], e[7]); }
            if (DIFF) { float e[8];
#pragma unroll
              for (int r = 0; r < 8; ++r) { e[r] = __builtin_amdgcn_exp2f(sb0[r]); }
              l2 += ((e[0] + e[1]) + (e[2] + e[3])) + ((e[4] + e[5]) + (e[6] + e[7]));
              wb0.x = cvtpk(e[0], e[1]); wb0.y = cvtpk(e[2], e[3]); wb0.z = cvtpk(e[4], e[5]); wb0.w = cvtpk(e[6], e[7]); }
#pragma unroll
            for (int d0 = 0; d0 < 2; ++d0) { s16x4 ml, mh; ATT_TR(ml, vpa, d0 * 4096); ATT_TR(mh, vpa, d0 * 4096 + 512); ATT_LGKM0(); const bf16x8 vf = ATT_VF(ml, mh);
                o1[d0] = __builtin_amdgcn_mfma_f32_32x32x16_bf16(__builtin_bit_cast(bf16x8, wa0), vf, o1[d0], 0, 0, 0);
                if (DIFF) o2[d0] = __builtin_amdgcn_mfma_f32_32x32x16_bf16(__builtin_bit_cast(bf16x8, wb0), vf, o2[d0], 0, 0, 0); }
        }
        { const int t_ = sl_cur; sl_cur = sl_n1; sl_n1 = sl_n2; sl_n2 = t_; }
    }
    ATT_BAR();
    bf16x8 qn[4];
    if (pn) {
#pragma unroll
        for (int d0 = 0; d0 < 4; ++d0) qn[d0] = *(const bf16x8*)(Sn.q + (size_t)r32 * 64 + d0 * 16 + hi * 8);
        ATT_DMA_S(Sn, 0, 0); ATT_DMA_S(Sn, 1, SLOTB); }
    l1 += shx(l1, 32, lane); if (DIFF) l2 += shx(l2, 32, lane); else l1 += sinkp;
    LAS float* wsf = (LAS float*)(lds + WS_OFF + wid * 256);
    if (hi == 0) { wsf[r32] = 1.0f / l1; if (DIFF) wsf[32 + r32] = lam / l2; }
    asm volatile("s_waitcnt lgkmcnt(0)" ::: "memory");
    LAS float* stg = (LAS float*)(lds + STG_OFF + wid * STG_W);
#pragma unroll
    for (int r = 0; r < 16; ++r) { const int qrow = crow(r, hi); const float i1 = wsf[qrow]; const float i2 = DIFF ? wsf[32 + qrow] : 0.f;
#pragma unroll
        for (int d0 = 0; d0 < 2; ++d0) stg[qrow * 68 + d0 * 32 + r32] = DIFF ? o1[d0][r] * i1 - o2[d0][r] * i2 : o1[d0][r] * i1; }
    asm volatile("s_waitcnt lgkmcnt(0)" ::: "memory");
    { const int row = lane >> 1, hf = lane & 1; const LAS f32x4* src = (const LAS f32x4*)(stg + row * 68 + hf * 32); f32x4 v[8]; float ss = 0.f;
#pragma unroll
      for (int i = 0; i < 8; ++i) { v[i] = src[i]; ss += (v[i][0] * v[i][0] + v[i][1] * v[i][1]) + (v[i][2] * v[i][2] + v[i][3] * v[i][3]); }
      float sc = 1.0f;
      if (DIFF) { ss += shx(ss, 1, lane); sc = rsqrtf(ss * (1.0f / 64.0f) + 1e-5f) * 0.8f; }
      bf16_t* dst = orow + (size_t)row * DM + hf * 32;
#pragma unroll
      for (int i = 0; i < 4; ++i) { f32x4 a = v[2 * i] * sc, c = v[2 * i + 1] * sc;
          if (DIFF) { a = a * *(const f32x4*)(p.g_dh + hf * 32 + 8 * i); c = c * *(const f32x4*)(p.g_dh + hf * 32 + 8 * i + 4); }
          u32x4 w; w.x = cvtpk(a[0], a[1]); w.y = cvtpk(a[2], a[3]); w.z = cvtpk(c[0], c[1]); w.w = cvtpk(c[2], c[3]); *(u32x4*)(dst + 8 * i) = w; } }
    if (pn) {
#pragma unroll
        for (int d0 = 0; d0 < 4; ++d0) qr[d0] = qn[d0]; }
#undef ATT_DMA
#undef ATT_DMA_S
}


constexpr int D_NSLOT = 4;
#define ATT_PIN(x) asm volatile("" : "+v"(x))
#define ATT_SB() __builtin_amdgcn_sched_barrier(0)
__device__ __forceinline__ float fadd_s(float a, float b) { float r; asm volatile("v_add_f32_e32 %0, %1, %2" : "=v"(r) : "v"(a), "v"(b)); return r; }
#define ATT_SUM8(P, B) fadd_s(fadd_s(fadd_s(P[B], P[B + 1]), fadd_s(P[B + 2], P[B + 3])), fadd_s(fadd_s(P[B + 4], P[B + 5]), fadd_s(P[B + 6], P[B + 7])))
template <bool HAVE_PREV, bool HAVE_NEXT> __device__ __forceinline__ void dstep(f32x16& ca, f32x16& cb, f32x16& pa, f32x16& pb, const bf16x8 (&kf)[4], bf16x8 (&kn)[4], const LAS unsigned char* kbn, unsigned vpa,
                                                                const bf16x8 (&qr)[4], f32x16 (&o1)[2], f32x16 (&o2)[2], float& l1, float& l2) {
    const f32x16 z = {0.f, 0.f, 0.f, 0.f, 0.f, 0.f, 0.f, 0.f, 0.f, 0.f, 0.f, 0.f, 0.f, 0.f, 0.f, 0.f};
    s16x4 vl[2][2], vh[2][2]; u32x4 wa[2], wb[2];
    ca = __builtin_amdgcn_mfma_f32_32x32x16_bf16(kf[0], qr[0], z, 0, 0, 0);
    float a0, a1, a2, a3, a4, a5, a6, a7, b0, b1, b2, b3, b4, b5, b6, b7;
    if (HAVE_PREV) { a0 = fadd_s(pa[0], pa[1]); a1 = fadd_s(pa[2], pa[3]); a2 = fadd_s(pa[4], pa[5]); a3 = fadd_s(pa[6], pa[7]); a4 = fadd_s(pa[8], pa[9]); a5 = fadd_s(pa[10], pa[11]); a6 = fadd_s(pa[12], pa[13]); a7 = fadd_s(pa[14], pa[15]);
        wa[0].x = cvtpk(pa[0], pa[1]); wa[0].y = cvtpk(pa[2], pa[3]); wa[0].z = cvtpk(pa[4], pa[5]); wa[0].w = cvtpk(pa[6], pa[7]); }
    ATT_SB();
    ca = __builtin_amdgcn_mfma_f32_32x32x16_bf16(kf[1], qr[1], ca, 0, 0, 0);
    if (HAVE_PREV) {
        ATT_TR(vl[0][0], vpa, 0); ATT_TR(vh[0][0], vpa, 512); ATT_TR(vl[1][0], vpa, 4096); ATT_TR(vh[1][0], vpa, 4096 + 512);
        ATT_TR(vl[0][1], vpa, 1024); ATT_TR(vh[0][1], vpa, 1024 + 512); ATT_TR(vl[1][1], vpa, 4096 + 1024); ATT_TR(vh[1][1], vpa, 4096 + 1024 + 512);
        a0 = fadd_s(a0, a1); a2 = fadd_s(a2, a3); a4 = fadd_s(a4, a5); a6 = fadd_s(a6, a7);
        wa[1].x = cvtpk(pa[8], pa[9]); wa[1].y = cvtpk(pa[10], pa[11]); wa[1].z = cvtpk(pa[12], pa[13]); wa[1].w = cvtpk(pa[14], pa[15]);
        a0 = fadd_s(a0, a2); a4 = fadd_s(a4, a6); }
    ATT_SB();
    cb = __builtin_amdgcn_mfma_f32_32x32x16_bf16(kf[2], qr[2], z, 0, 0, 0);
    if (HAVE_PREV) { b0 = fadd_s(pb[0], pb[1]); b1 = fadd_s(pb[2], pb[3]); b2 = fadd_s(pb[4], pb[5]); b3 = fadd_s(pb[6], pb[7]); b4 = fadd_s(pb[8], pb[9]); b5 = fadd_s(pb[10], pb[11]); b6 = fadd_s(pb[12], pb[13]); b7 = fadd_s(pb[14], pb[15]);
        wb[0].x = cvtpk(pb[0], pb[1]); wb[0].y = cvtpk(pb[2], pb[3]); wb[0].z = cvtpk(pb[4], pb[5]); wb[0].w = cvtpk(pb[6], pb[7]);
        a0 = fadd_s(a0, a4); }
    ATT_SB();
    cb = __builtin_amdgcn_mfma_f32_32x32x16_bf16(kf[3], qr[3], cb, 0, 0, 0);
    if (HAVE_PREV) { b0 = fadd_s(b0, b1); b2 = fadd_s(b2, b3); b4 = fadd_s(b4, b5); b6 = fadd_s(b6, b7);
        wb[1].x = cvtpk(pb[8], pb[9]); wb[1].y = cvtpk(pb[10], pb[11]); wb[1].z = cvtpk(pb[12], pb[13]); wb[1].w = cvtpk(pb[14], pb[15]);
        b0 = fadd_s(b0, b2); b4 = fadd_s(b4, b6); l1 = fadd_s(l1, a0); b0 = fadd_s(b0, b4); }
    asm volatile("s_waitcnt lgkmcnt(0)" ::: "memory"); ATT_SB();
#if defined(PROBE_MFMA2)
    f32x16 dmy = z;
#define ATT_DUP(A, B) do { if (HAVE_PREV) { dmy = __builtin_amdgcn_mfma_f32_32x32x16_bf16(A, B, dmy, 0, 0, 0); } } while (0)
#else
#define ATT_DUP(A, B) do { } while (0)
#endif
    if (HAVE_PREV) l2 = fadd_s(l2, b0);
#if defined(PROBE_EXP2)
#define ATT_EX4(X, B) do { float d0_ = __builtin_amdgcn_exp2f(X[B] + 0.0f), d1_ = __builtin_amdgcn_exp2f(X[B + 1] + 0.0f), d2_ = __builtin_amdgcn_exp2f(X[B + 2] + 0.0f), d3_ = __builtin_amdgcn_exp2f(X[B + 3] + 0.0f); asm volatile("" :: "v"(d0_), "v"(d1_), "v"(d2_), "v"(d3_)); \
    X[B] = __builtin_amdgcn_exp2f(X[B]); X[B + 1] = __builtin_amdgcn_exp2f(X[B + 1]); X[B + 2] = __builtin_amdgcn_exp2f(X[B + 2]); X[B + 3] = __builtin_amdgcn_exp2f(X[B + 3]); ATT_PIN(X); } while (0)
#else
#define ATT_EX4(X, B) do { X[B] = __builtin_amdgcn_exp2f(X[B]); X[B + 1] = __builtin_amdgcn_exp2f(X[B + 1]); X[B + 2] = __builtin_amdgcn_exp2f(X[B + 2]); X[B + 3] = __builtin_amdgcn_exp2f(X[B + 3]); ATT_PIN(X); } while (0)
#endif
    if (HAVE_NEXT) { kn[0] = *(const LAS bf16x8*)(kbn); kn[1] = *(const LAS bf16x8*)(kbn + 2048); kn[2] = *(const LAS bf16x8*)(kbn + 4096); kn[3] = *(const LAS bf16x8*)(kbn + 6144); }
    if (HAVE_PREV) o1[0] = __builtin_amdgcn_mfma_f32_32x32x16_bf16(__builtin_bit_cast(bf16x8, wa[0]), ATT_VF(vl[0][0], vh[0][0]), o1[0], 0, 0, 0);
    ATT_DUP(__builtin_bit_cast(bf16x8, wa[0]), ATT_VF(vl[0][0], vh[0][0]));
    ATT_EX4(ca, 0); ATT_SB();
    if (HAVE_PREV) o1[1] = __builtin_amdgcn_mfma_f32_32x32x16_bf16(__builtin_bit_cast(bf16x8, wa[0]), ATT_VF(vl[1][0], vh[1][0]), o1[1], 0, 0, 0);
    ATT_DUP(__builtin_bit_cast(bf16x8, wa[0]), ATT_VF(vl[1][0], vh[1][0]));
    ATT_EX4(ca, 4); ATT_SB();
    if (HAVE_PREV) o2[0] = __builtin_amdgcn_mfma_f32_32x32x16_bf16(__builtin_bit_cast(bf16x8, wb[0]), ATT_VF(vl[0][0], vh[0][0]), o2[0], 0, 0, 0);
    ATT_DUP(__builtin_bit_cast(bf16x8, wb[0]), ATT_VF(vl[0][0], vh[0][0]));
    ATT_EX4(ca, 8); ATT_SB();
    if (HAVE_PREV) o2[1] = __builtin_amdgcn_mfma_f32_32x32x16_bf16(__builtin_bit_cast(bf16x8, wb[0]), ATT_VF(vl[1][0], vh[1][0]), o2[1], 0, 0, 0);
    ATT_DUP(__builtin_bit_cast(bf16x8, wb[0]), ATT_VF(vl[1][0], vh[1][0]));
    ATT_EX4(ca, 12); ATT_SB();
    if (HAVE_PREV) o1[0] = __builtin_amdgcn_mfma_f32_32x32x16_bf16(__builtin_bit_cast(bf16x8, wa[1]), ATT_VF(vl[0][1], vh[0][1]), o1[0], 0, 0, 0);
    ATT_DUP(__builtin_bit_cast(bf16x8, wa[1]), ATT_VF(vl[0][1], vh[0][1]));
    ATT_EX4(cb, 0); ATT_SB();
    if (HAVE_PREV) o1[1] = __builtin_amdgcn_mfma_f32_32x32x16_bf16(__builtin_bit_cast(bf16x8, wa[1]), ATT_VF(vl[1][1], vh[1][1]), o1[1], 0, 0, 0);
    ATT_DUP(__builtin_bit_cast(bf16x8, wa[1]), ATT_VF(vl[1][1], vh[1][1]));
    ATT_EX4(cb, 4); ATT_SB();
    if (HAVE_PREV) o2[0] = __builtin_amdgcn_mfma_f32_32x32x16_bf16(__builtin_bit_cast(bf16x8, wb[1]), ATT_VF(vl[0][1], vh[0][1]), o2[0], 0, 0, 0);
    ATT_DUP(__builtin_bit_cast(bf16x8, wb[1]), ATT_VF(vl[0][1], vh[0][1]));
    ATT_EX4(cb, 8); ATT_SB();
    if (HAVE_PREV) o2[1] = __builtin_amdgcn_mfma_f32_32x32x16_bf16(__builtin_bit_cast(bf16x8, wb[1]), ATT_VF(vl[1][1], vh[1][1]), o2[1], 0, 0, 0);
    ATT_DUP(__builtin_bit_cast(bf16x8, wb[1]), ATT_VF(vl[1][1], vh[1][1]));
    ATT_EX4(cb, 12); ATT_SB();
#if defined(PROBE_MFMA2)
    asm volatile("" :: "v"(dmy));
#endif
#undef ATT_DUP
#undef ATT_EX4
}
__device__ __forceinline__ void unit_diff(const P& p, LAS unsigned char* lds, const Src& S, float lam, bf16_t* orow, const int wid,
                                          bf16x8 (&qr)[4], const bool pre  , const bool pn  , const Src& Sn) {
    const int lane = fresh_lane(), tid = wid * 64 + lane, r32 = lane & 31, hi = lane >> 5;
    constexpr int NTR = 64;
#define ATT_DMA_S(SS, j, slot) do { const bf16_t* ks_ = (j) < NTR ? SS.k + (size_t)(j) * TILE_EL : SS.km; const bf16_t* vs_ = (j) < NTR ? SS.v + (size_t)(j) * TILE_EL : SS.vm; \
        __builtin_amdgcn_global_load_lds((const unsigned*)(ks_ + tid * 8), (LAS unsigned*)(lds + (slot) + wid * 1024), 16, 0, 0); \
        __builtin_amdgcn_global_load_lds((const unsigned*)(vs_ + tid * 8), (LAS unsigned*)(lds + (slot) + 8192 + wid * 1024), 16, 0, 0); } while (0)
#define ATT_DMA(j, slot) ATT_DMA_S(S, j, slot)
    if (!pre) {
#pragma unroll
        for (int d0 = 0; d0 < 4; ++d0) qr[d0] = *(const bf16x8*)(S.q + (size_t)r32 * 64 + d0 * 16 + hi * 8);
        ATT_DMA(0, 0); ATT_DMA(1, SLOTB); }
    f32x16 o1[2], o2[2];
#pragma unroll
    for (int d = 0; d < 2; ++d)
#pragma unroll
        for (int r = 0; r < 16; ++r) { o1[d][r] = 0.f; o2[d][r] = 0.f; }
    float l1 = 0.f, l2 = 0.f;
    const int koff = hi * 1024 + r32 * 16;
    const int voff = 8192 + ((lane >> 4) & 1) * 32 + (lane & 3) * 8 + (4 * hi + ((lane & 15) >> 2)) * 64;
    const unsigned lbase = (unsigned)(__SIZE_TYPE__)lds;
    f32x16 A0, B0, A1, B1; bf16x8 kA[4], kB[4];
    ATT_WAITV(0); ATT_BAR(); ATT_DMA(2, 2 * SLOTB); ATT_DMA(3, 3 * SLOTB);
#pragma unroll
    for (int d0 = 0; d0 < 4; ++d0) kA[d0] = *(const LAS bf16x8*)(lds + koff + d0 * 2048);
    dstep<false, true>(A0, B0, A1, B1, kA, kB, lds + koff + 512, 0u, qr, o1, o2, l1, l2);
    dstep<true, true>(A1, B1, A0, B0, kB, kA, lds + SLOTB + koff, lbase + voff, qr, o1, o2, l1, l2);
    int sl_prev = 0, sl_cur = SLOTB, sl_nxt = 2 * SLOTB, sl_n2 = 3 * SLOTB, sl_dma = 4 * SLOTB;
    for (int T = 1; T < NTR; ++T) {
        if (T + 2 <= NTR) ATT_WAITV(2); else ATT_WAITV(0);
        ATT_BAR();
        if (T + 3 <= NTR) ATT_DMA(T + 3, sl_dma);
        dstep<true, true>(A0, B0, A1, B1, kA, kB, lds + sl_cur + koff + 512, lbase + sl_prev + voff + 2048, qr, o1, o2, l1, l2);
        dstep<true, true>(A1, B1, A0, B0, kB, kA, lds + sl_nxt + koff, lbase + sl_cur + voff, qr, o1, o2, l1, l2);
        { const int f_ = sl_prev; sl_prev = sl_cur; sl_cur = sl_nxt; sl_nxt = sl_n2; sl_n2 = sl_dma; sl_dma = f_; }
    }
    ATT_WAITV(0); ATT_BAR();
    dstep<true, false>(A0, B0, A1, B1, kA, kB, lds, lbase + sl_prev + voff + 2048, qr, o1, o2, l1, l2);
#pragma unroll
    for (int r = 8; r < 16; ++r) { A0[r] = 0.f; B0[r] = 0.f; }
    {
        l1 += ((A0[0] + A0[1]) + (A0[2] + A0[3])) + ((A0[4] + A0[5]) + (A0[6] + A0[7])); l2 += ((B0[0] + B0[1]) + (B0[2] + B0[3])) + ((B0[4] + B0[5]) + (B0[6] + B0[7]));
        u32x4 wa, wb; wa.x = cvtpk(A0[0], A0[1]); wa.y = cvtpk(A0[2], A0[3]); wa.z = cvtpk(A0[4], A0[5]); wa.w = cvtpk(A0[6], A0[7]); wb.x = cvtpk(B0[0], B0[1]); wb.y = cvtpk(B0[2], B0[3]); wb.z = cvtpk(B0[4], B0[5]); wb.w = cvtpk(B0[6], B0[7]);
        const unsigned vpa = lbase + sl_cur + voff;
#pragma unroll
        for (int d0 = 0; d0 < 2; ++d0) { s16x4 ml, mh; ATT_TR(ml, vpa, d0 * 4096); ATT_TR(mh, vpa, d0 * 4096 + 512); ATT_LGKM0(); const bf16x8 vf = ATT_VF(ml, mh);
            o1[d0] = __builtin_amdgcn_mfma_f32_32x32x16_bf16(__builtin_bit_cast(bf16x8, wa), vf, o1[d0], 0, 0, 0); o2[d0] = __builtin_amdgcn_mfma_f32_32x32x16_bf16(__builtin_bit_cast(bf16x8, wb), vf, o2[d0], 0, 0, 0); } }
    ATT_BAR();
    bf16x8 qn[4];
    if (pn) {
#pragma unroll
        for (int d0 = 0; d0 < 4; ++d0) qn[d0] = *(const bf16x8*)(Sn.q + (size_t)r32 * 64 + d0 * 16 + hi * 8);
        ATT_DMA_S(Sn, 0, 0); ATT_DMA_S(Sn, 1, SLOTB); }
    l1 += shx(l1, 32, lane); l2 += shx(l2, 32, lane);
    LAS float* wsf = (LAS float*)(lds + WS_OFF + wid * 256);
    if (hi == 0) { wsf[r32] = 1.0f / l1; wsf[32 + r32] = lam / l2; }
    asm volatile("s_waitcnt lgkmcnt(0)" ::: "memory");
    LAS float* stg = (LAS float*)(lds + 2 * SLOTB + wid * STG_W);
#pragma unroll
    for (int r = 0; r < 16; ++r) { const int qrow = crow(r, hi); const float i1 = wsf[qrow], i2 = wsf[32 + qrow];
#pragma unroll
        for (int d0 = 0; d0 < 2; ++d0) stg[qrow * 68 + d0 * 32 + r32] = o1[d0][r] * i1 - o2[d0][r] * i2; }
    asm volatile("s_waitcnt lgkmcnt(0)" ::: "memory");
    { const int row = lane >> 1, hf = lane & 1; const LAS f32x4* src = (const LAS f32x4*)(stg + row * 68 + hf * 32); f32x4 v[8]; float ss = 0.f;
#pragma unroll
      for (int i = 0; i < 8; ++i) { v[i] = src[i]; ss += (v[i][0] * v[i][0] + v[i][1] * v[i][1]) + (v[i][2] * v[i][2] + v[i][3] * v[i][3]); }
      ss += shx(ss, 1, lane); const float sc = rsqrtf(ss * (1.0f / 64.0f) + 1e-5f) * 0.8f;
      bf16_t* dst = orow + (size_t)row * DM + hf * 32;
      const LAS float* gdh = (const LAS float*)(lds + GDH_OFF);
#pragma unroll
      for (int i = 0; i < 4; ++i) { const f32x4 a = v[2 * i] * sc * *(const LAS f32x4*)(gdh + hf * 32 + 8 * i), c = v[2 * i + 1] * sc * *(const LAS f32x4*)(gdh + hf * 32 + 8 * i + 4);
          u32x4 w; w.x = cvtpk(a[0], a[1]); w.y = cvtpk(a[2], a[3]); w.z = cvtpk(c[0], c[1]); w.w = cvtpk(c[2], c[3]); *(u32x4*)(dst + 8 * i) = w; } }
    if (pn) {
#pragma unroll
        for (int d0 = 0; d0 < 4; ++d0) qr[d0] = qn[d0]; }
    else ATT_BAR();
#undef ATT_DMA
#undef ATT_DMA_S
}

template <bool HAVE_PREV, bool HAVE_NEXT> __device__ __forceinline__ void sstep(f32x16& ca, f32x16& pa, const bf16x8 (&kf)[4], bf16x8 (&kn)[4], const LAS unsigned char* kbn, unsigned vpa,
                                                                const bf16x8 (&qr)[4], f32x16 (&o1)[2], float& l1, const bool full, const int dq  ) {
    const f32x16 z = {0.f, 0.f, 0.f, 0.f, 0.f, 0.f, 0.f, 0.f, 0.f, 0.f, 0.f, 0.f, 0.f, 0.f, 0.f, 0.f};
    s16x4 vl[2][2], vh[2][2]; u32x4 wa[2];
    ca = __builtin_amdgcn_mfma_f32_32x32x16_bf16(kf[0], qr[0], z, 0, 0, 0);
    float a0, a1, a2, a3, a4, a5, a6, a7;
    if (HAVE_PREV) { a0 = fadd_s(pa[0], pa[1]); a1 = fadd_s(pa[2], pa[3]); a2 = fadd_s(pa[4], pa[5]); a3 = fadd_s(pa[6], pa[7]); a4 = fadd_s(pa[8], pa[9]); a5 = fadd_s(pa[10], pa[11]); a6 = fadd_s(pa[12], pa[13]); a7 = fadd_s(pa[14], pa[15]);
        wa[0].x = cvtpk(pa[0], pa[1]); wa[0].y = cvtpk(pa[2], pa[3]); wa[0].z = cvtpk(pa[4], pa[5]); wa[0].w = cvtpk(pa[6], pa[7]); }
    ATT_SB();
    ca = __builtin_amdgcn_mfma_f32_32x32x16_bf16(kf[1], qr[1], ca, 0, 0, 0);
    if (HAVE_PREV) {
        ATT_TR(vl[0][0], vpa, 0); ATT_TR(vh[0][0], vpa, 512); ATT_TR(vl[1][0], vpa, 4096); ATT_TR(vh[1][0], vpa, 4096 + 512);
        ATT_TR(vl[0][1], vpa, 1024); ATT_TR(vh[0][1], vpa, 1024 + 512); ATT_TR(vl[1][1], vpa, 4096 + 1024); ATT_TR(vh[1][1], vpa, 4096 + 1024 + 512);
        a0 = fadd_s(a0, a1); a2 = fadd_s(a2, a3); a4 = fadd_s(a4, a5); a6 = fadd_s(a6, a7);
        wa[1].x = cvtpk(pa[8], pa[9]); wa[1].y = cvtpk(pa[10], pa[11]); wa[1].z = cvtpk(pa[12], pa[13]); wa[1].w = cvtpk(pa[14], pa[15]); }
    ATT_SB();
    ca = __builtin_amdgcn_mfma_f32_32x32x16_bf16(kf[2], qr[2], ca, 0, 0, 0);
    if (HAVE_PREV) { a0 = fadd_s(a0, a2); a4 = fadd_s(a4, a6); }
    ATT_SB();
    ca = __builtin_amdgcn_mfma_f32_32x32x16_bf16(kf[3], qr[3], ca, 0, 0, 0);
    if (HAVE_PREV) { a0 = fadd_s(a0, a4); l1 = fadd_s(l1, a0); }
    asm volatile("s_waitcnt lgkmcnt(0)" ::: "memory"); ATT_SB();
#define ATT_EX4(X, B) do { X[B] = __builtin_amdgcn_exp2f(X[B]); X[B + 1] = __builtin_amdgcn_exp2f(X[B + 1]); X[B + 2] = __builtin_amdgcn_exp2f(X[B + 2]); X[B + 3] = __builtin_amdgcn_exp2f(X[B + 3]); ATT_PIN(X); } while (0)
    if (HAVE_NEXT) { kn[0] = *(const LAS bf16x8*)(kbn); kn[1] = *(const LAS bf16x8*)(kbn + 2048); kn[2] = *(const LAS bf16x8*)(kbn + 4096); kn[3] = *(const LAS bf16x8*)(kbn + 6144); }
    if (HAVE_PREV) o1[0] = __builtin_amdgcn_mfma_f32_32x32x16_bf16(__builtin_bit_cast(bf16x8, wa[0]), ATT_VF(vl[0][0], vh[0][0]), o1[0], 0, 0, 0);
    if (!full) {
#pragma unroll
        for (int r = 0; r < 16; ++r) { const int d = dq - ((r & 3) + 8 * (r >> 2)); if (d > 128 || d < -128) ca[r] = -INFINITY; } }
    ATT_EX4(ca, 0); ATT_SB();
    if (HAVE_PREV) o1[1] = __builtin_amdgcn_mfma_f32_32x32x16_bf16(__builtin_bit_cast(bf16x8, wa[0]), ATT_VF(vl[1][0], vh[1][0]), o1[1], 0, 0, 0);
    ATT_EX4(ca, 4); ATT_SB();
    if (HAVE_PREV) o1[0] = __builtin_amdgcn_mfma_f32_32x32x16_bf16(__builtin_bit_cast(bf16x8, wa[1]), ATT_VF(vl[0][1], vh[0][1]), o1[0], 0, 0, 0);
    ATT_EX4(ca, 8); ATT_SB();
    if (HAVE_PREV) o1[1] = __builtin_amdgcn_mfma_f32_32x32x16_bf16(__builtin_bit_cast(bf16x8, wa[1]), ATT_VF(vl[1][1], vh[1][1]), o1[1], 0, 0, 0);
    ATT_EX4(ca, 12); ATT_SB();
#undef ATT_EX4
}
__device__ __forceinline__ void unit_swa(const P& p, LAS unsigned char* lds, const Src& S, const int qa  , const float sinkp, bf16_t* orow, const int wid,
                                         bf16x8 (&qr)[4], const bool pre, const bool pn, const Src& Sn) {
    const int lane = fresh_lane(), tid = wid * 64 + lane, r32 = lane & 31, hi = lane >> 5;
    const int NTR = S.ntr;
#define ATT_DMA_S(SS, j, slot) do { const bf16_t* ks_ = (j) < SS.ntr ? SS.k + (size_t)(SS.t0 + (j)) * TILE_EL : SS.km; const bf16_t* vs_ = (j) < SS.ntr ? SS.v + (size_t)(SS.t0 + (j)) * TILE_EL : SS.vm; \
        __builtin_amdgcn_global_load_lds((const unsigned*)(ks_ + tid * 8), (LAS unsigned*)(lds + (slot) + wid * 1024), 16, 0, 0); \
        __builtin_amdgcn_global_load_lds((const unsigned*)(vs_ + tid * 8), (LAS unsigned*)(lds + (slot) + 8192 + wid * 1024), 16, 0, 0); } while (0)
#define ATT_DMA(j, slot) ATT_DMA_S(S, j, slot)
    if (!pre) {
#pragma unroll
        for (int d0 = 0; d0 < 4; ++d0) qr[d0] = *(const bf16x8*)(S.q + (size_t)r32 * 64 + d0 * 16 + hi * 8);
        ATT_DMA(0, 0); ATT_DMA(1, SLOTB); }
    f32x16 o1[2];
#pragma unroll
    for (int d = 0; d < 2; ++d)
#pragma unroll
        for (int r = 0; r < 16; ++r) o1[d][r] = 0.f;
    float l1 = 0.f;
    const int koff = hi * 1024 + r32 * 16;
    const int voff = 8192 + ((lane >> 4) & 1) * 32 + (lane & 3) * 8 + (4 * hi + ((lane & 15) >> 2)) * 64;
    const unsigned lbase = (unsigned)(__SIZE_TYPE__)lds;
    const int k00 = 64 * S.t0;
#define SW_FULL(T, b) ((qa + 31 - (k00 + 64 * (T) + 32 * (b)) <= 128) && ((k00 + 64 * (T) + 32 * (b)) + 31 - qa <= 128))
#define SW_DQ(T, b) (qa + r32 - (k00 + 64 * (T) + 32 * (b)) - 4 * hi)
    f32x16 A0, A1; bf16x8 kA[4], kB[4];
    ATT_WAITV(0); ATT_BAR(); ATT_DMA(2, 2 * SLOTB); ATT_DMA(3, 3 * SLOTB);
#pragma unroll
    for (int d0 = 0; d0 < 4; ++d0) kA[d0] = *(const LAS bf16x8*)(lds + koff + d0 * 2048);
    sstep<false, true>(A0, A1, kA, kB, lds + koff + 512, 0u, qr, o1, l1, SW_FULL(0, 0), SW_DQ(0, 0));
    sstep<true, true>(A1, A0, kB, kA, lds + SLOTB + koff, lbase + voff, qr, o1, l1, SW_FULL(0, 1), SW_DQ(0, 1));
    int sl_prev = 0, sl_cur = SLOTB, sl_nxt = 2 * SLOTB, sl_n2 = 3 * SLOTB, sl_dma = 4 * SLOTB;
    for (int T = 1; T < NTR; ++T) {
        if (T + 2 <= NTR) ATT_WAITV(2); else ATT_WAITV(0);
        ATT_BAR();
        if (T + 3 <= NTR) ATT_DMA(T + 3, sl_dma);
        sstep<true, true>(A0, A1, kA, kB, lds + sl_cur + koff + 512, lbase + sl_prev + voff + 2048, qr, o1, l1, SW_FULL(T, 0), SW_DQ(T, 0));
        sstep<true, true>(A1, A0, kB, kA, lds + sl_nxt + koff, lbase + sl_cur + voff, qr, o1, l1, SW_FULL(T, 1), SW_DQ(T, 1));
        { const int f_ = sl_prev; sl_prev = sl_cur; sl_cur = sl_nxt; sl_nxt = sl_n2; sl_n2 = sl_dma; sl_dma = f_; }
    }
    ATT_WAITV(0); ATT_BAR();
    sstep<true, false>(A0, A1, kA, kB, lds, lbase + sl_prev + voff + 2048, qr, o1, l1, true, 0);
#undef SW_FULL
#undef SW_DQ
    {
        l1 += ((A0[0] + A0[1]) + (A0[2] + A0[3])) + ((A0[4] + A0[5]) + (A0[6] + A0[7]));
        u32x4 wa; wa.x = cvtpk(A0[0], A0[1]); wa.y = cvtpk(A0[2], A0[3]); wa.z = cvtpk(A0[4], A0[5]); wa.w = cvtpk(A0[6], A0[7]);
        const unsigned vpa = lbase + sl_cur + voff;
#pragma unroll
        for (int d0 = 0; d0 < 2; ++d0) { s16x4 ml, mh; ATT_TR(ml, vpa, d0 * 4096); ATT_TR(mh, vpa, d0 * 4096 + 512); ATT_LGKM0(); const bf16x8 vf = ATT_VF(ml, mh);
            o1[d0] = __builtin_amdgcn_mfma_f32_32x32x16_bf16(__builtin_bit_cast(bf16x8, wa), vf, o1[d0], 0, 0, 0); } }
    ATT_BAR();
    bf16x8 qn[4];
    if (pn) {
#pragma unroll
        for (int d0 = 0; d0 < 4; ++d0) qn[d0] = *(const bf16x8*)(Sn.q + (size_t)r32 * 64 + d0 * 16 + hi * 8);
        ATT_DMA_S(Sn, 0, 0); ATT_DMA_S(Sn, 1, SLOTB); }
    l1 += shx(l1, 32, lane); l1 += sinkp;
    LAS float* wsf = (LAS float*)(lds + WS_OFF + wid * 256);
    if (hi == 0) wsf[r32] = 1.0f / l1;
    asm volatile("s_waitcnt lgkmcnt(0)" ::: "memory");
    LAS float* stg = (LAS float*)(lds + 2 * SLOTB + wid * STG_W);
#pragma unroll
    for (int r = 0; r < 16; ++r) { const int qrow = crow(r, hi); const float i1 = wsf[qrow];
#pragma unroll
        for (int d0 = 0; d0 < 2; ++d0) stg[qrow * 68 + d0 * 32 + r32] = o1[d0][r] * i1; }
    asm volatile("s_waitcnt lgkmcnt(0)" ::: "memory");
    { const int row = lane >> 1, hf = lane & 1; const LAS f32x4* src = (const LAS f32x4*)(stg + row * 68 + hf * 32); bf16_t* dst = orow + (size_t)row * DM + hf * 32;
#pragma unroll
      for (int i = 0; i < 4; ++i) { const f32x4 a = src[2 * i], c = src[2 * i + 1];
          u32x4 w; w.x = cvtpk(a[0], a[1]); w.y = cvtpk(a[2], a[3]); w.z = cvtpk(c[0], c[1]); w.w = cvtpk(c[2], c[3]); *(u32x4*)(dst + 8 * i) = w; } }
    if (pn) {
#pragma unroll
        for (int d0 = 0; d0 < 4; ++d0) qr[d0] = qn[d0]; }
    else ATT_BAR();
#undef ATT_DMA
#undef ATT_DMA_S
}

__device__ __forceinline__ void phase(const P& p, LAS unsigned char* lds, int G, int vcu, const int wid) {
    const int lane = fresh_lane();
    const bf16_t* MT = (const bf16_t*)(p.ws + WS_META); bf16_t* MX = (bf16_t*)(p.ws + WS_MIXED);
    float sa = lane < 32 ? p.lq1[lane] * p.lk1[lane] : 0.f, sb = lane < 32 ? p.lq2[lane] * p.lk2[lane] : 0.f;
#pragma unroll
    for (int o = 1; o < 64; o <<= 1) { sa += shx(sa, o, lane); sb += shx(sb, o, lane); }
    const float lam = __expf(sa) - __expf(sb) + 0.2f;
    const int cslot = vcu & 15; int iter = 0;
    { LAS float* gdh = (LAS float*)(lds + GDH_OFF); if (wid == 0) gdh[lane] = p.g_dh[lane]; ATT_BAR(); }
    bf16x8 qrd[4]; bool pred = false;
#define ATT_DIFF_SRC(UU, SS, HH, TOK0, BB) const int qb_##SS = (UU) & 15, bh_##SS = (UU) >> 4; const int HH = bh_##SS & 7, BB = bh_##SS >> 3, TOK0 = qb_##SS * 256 + wid * 32; \
        const Src SS{(const bf16_t*)(p.ws + WS_QB) + ((size_t)bh_##SS * SEQ + TOK0) * 64, (const bf16_t*)(p.ws + WS_KB) + (size_t)bh_##SS * HEAD_EL, (const bf16_t*)(p.ws + WS_VB) + (size_t)bh_##SS * HEAD_EL, MT + (4 + HH) * TILE_EL, MT + (12 + HH) * TILE_EL, 0, 64}
    for (int U = vcu; U < NB * 8 * 16; U += G) {
        if (iter++ == cslot) { ATT_BAR(); f8_share(p, lds, G, vcu, wid); ATT_BAR(); }
        ATT_DIFF_SRC(U, S, h, tok0, b);
        const int Un = U + G; const bool pn = Un < NB * 8 * 16 && iter != cslot;
        ATT_DIFF_SRC(pn ? Un : U, Sn, hn, tok0n, bn);
        unit_diff(p, lds, S, lam, MX + ((size_t)b * SEQ + tok0) * DM + 512 + h * 64, wid, qrd, pred, pn, Sn);
        pred = pn;
    }
#undef ATT_DIFF_SRC
    bf16x8 qra[4]; bool pre = false;
#define ATT_SWA_SRC(UU, SS, HQ, TOK0, BB) const int gp_##SS = (UU) & 1, nq_##SS = ((UU) >> 1) & 31, bk_##SS = (UU) >> 6, kvh_##SS = bk_##SS & 1; const int BB = bk_##SS >> 1, HQ = kvh_##SS * 4 + gp_##SS * 2 + (wid >> 2), TOK0 = nq_##SS * 128 + (wid & 3) * 32; \
        const int tlo_##SS = 2 * nq_##SS - 2 < 0 ? 0 : 2 * nq_##SS - 2, thi_##SS = 2 * nq_##SS + 3 > 63 ? 63 : 2 * nq_##SS + 3; \
        const Src SS{(const bf16_t*)(p.ws + WS_QA) + ((size_t)(BB * 8 + HQ) * SEQ + TOK0) * 64, (const bf16_t*)(p.ws + WS_KA) + (size_t)bk_##SS * HEAD_EL, (const bf16_t*)(p.ws + WS_VA) + (size_t)bk_##SS * HEAD_EL, MT + kvh_##SS * TILE_EL, MT + (2 + kvh_##SS) * TILE_EL, tlo_##SS, thi_##SS - tlo_##SS + 1}
    for (int U = vcu; U < NB * 2 * 32 * 2; U += G) {
        if (iter++ == cslot) { ATT_BAR(); f8_share(p, lds, G, vcu, wid); ATT_BAR(); }
        ATT_SWA_SRC(U, S, hq, tok0, b);
        const int Un = U + G; const bool pn = Un < NB * 2 * 32 * 2 && iter != cslot;
        ATT_SWA_SRC(pn ? Un : U, Sn, hqn, tok0n, bn);
        unit_swa(p, lds, S, tok0, exp2f(p.sink[hq] * LOG2E), MX + ((size_t)b * SEQ + tok0) * DM + hq * 64, wid, qra, pre, pn, Sn);
        pre = pn;
    }
#undef ATT_SWA_SRC
    ATT_BAR();
    if (iter <= cslot) f8_share(p, lds, G, vcu, wid);
}
#undef ATT_WAITV
#undef ATT_BAR
}


struct Args { P p; int ph_lo, ph_hi; };
constexpr int NPHASE = 8;

struct Ctx { const P* pp; LAS unsigned char* lds; int G, bx, vcu, wave; unsigned* ctl; };

__device__ __forceinline__ void meta_task(const Ctx& c, int hs) {
    const P& p = *c.pp; const int hc = hs < 4 ? 8 + hs : 16 + hs, wave = c.wave, lane = fresh_lane(), tid = wave * 64 + lane;
    LAS float* xm = (LAS float*)(c.lds + RING_OFF); LAS float* part = (LAS float*)(c.lds + RING_OFF + 65536); LAS float* vout = (LAS float*)(c.lds + RING_OFF + 98304);
    bf16_t* tile = (bf16_t*)(p.ws + WS_META) + (hc < 10 ? hc - 8 : hc < 12 ? 2 + (hc - 10) : hc < 28 ? 4 + (hc - 20) : 12 + (hc - 28)) * TILE_EL;
    for (int i = tid; i < TILE_EL / 2; i += NWAVES * 64) ((unsigned*)tile)[i] = 0u;
    for (int rr = 0; rr < 2; ++rr) { const int row = 2 * wave + rr; const float* xr = p.meta + (size_t)row * DM; f32x4 v[4]; float s = 0.f;
#pragma unroll
        for (int j = 0; j < 4; ++j) { v[j] = ((const f32x4*)xr)[lane + 64 * j]; s += (v[j][0] * v[j][0] + v[j][1] * v[j][1]) + (v[j][2] * v[j][2] + v[j][3] * v[j][3]); }
#pragma unroll
        for (int o = 1; o < 64; o <<= 1) s += shx(s, o, lane);
        const float rs = rsqrtf(s * (1.0f / DM) + EPS);
#pragma unroll
        for (int j = 0; j < 4; ++j) { const f32x4 g = ((const f32x4*)p.g_attn)[lane + 64 * j]; ((LAS f32x4*)(xm + row * DM))[lane + 64 * j] = v[j] * rs * g; } }
    __syncthreads();
    { float acc[16];
#pragma unroll
      for (int r = 0; r < 16; ++r) acc[r] = 0.f;
      const float* wp = p.w_in + (size_t)(128 * wave) * INW + hc * 64 + lane;
      for (int k0 = 0; k0 < 128; k0 += 32) { float w[32];
#pragma unroll
          for (int k = 0; k < 32; ++k) w[k] = wp[(size_t)(k0 + k) * INW];
#pragma unroll
          for (int k = 0; k < 32; ++k) {
#pragma unroll
              for (int r = 0; r < 16; ++r) acc[r] += xm[r * DM + 128 * wave + k0 + k] * w[k]; } }
#pragma unroll
      for (int r = 0; r < 16; ++r) part[(wave * 16 + r) * 64 + lane] = acc[r]; }
    __syncthreads();
    for (int o = tid; o < 16 * 64; o += NWAVES * 64) { float s = 0.f;
#pragma unroll
        for (int kg = 0; kg < 8; ++kg) s += part[kg * 1024 + o];
        vout[o] = s; }
    __syncthreads();
    LAS float* csm = (LAS float*)(c.lds + RING_OFF + 65536);
    { const int pos = tid >> 5, f = tid & 31; const float ang = (float)pos * powf(10000.0f, -(float)(2 * f) / 64.0f); csm[2 * tid] = cosf(ang); csm[2 * tid + 1] = sinf(ang);
      if (tid < 256) { const int pos2 = tid >> 4, f2 = tid & 15; const float ang2 = (float)pos2 * powf(10000.0f, -(float)(2 * f2) / 32.0f); csm[1024 + 2 * tid] = cosf(ang2); csm[1024 + 2 * tid + 1] = sinf(ang2); } }
    __syncthreads();
    if (tid < 16) headpost(p, T + tid, hc, (float*)(vout + tid * 64), (const float2*)(float*)(csm + tid * 64), (const float2*)(float*)(csm + 1024 + tid * 32));
    __syncthreads();
}
__device__ __forceinline__ void ph0(const Ctx& c) {
    const P& p = *c.pp; const int wave = c.wave, G = c.G, vcu = c.vcu, lane = fresh_lane(), tid = wave * 64 + lane;
    if (vcu < 20) meta_task(c, vcu);
    if (vcu == 20) { bf16_t* wh = (bf16_t*)(p.ws + WS_WRT); bf16_t* wl = wh + NE * DM;
        for (int i = tid; i < NE * DM; i += NWAVES * 64) { const int k = i >> 5, e = i & 31; const float w = p.w_router[i]; const bf16_t h = f2bf(w); wh[e * DM + k] = h; wl[e * DM + k] = f2bf(w - bf2f(h)); } }
    LAS float* scr = (LAS float*)(c.lds + RING_OFF + wave * 16384);
    const int gw = vcu * NWAVES + wave, NGW = G * NWAVES;
    constexpr int I_IN = 16 * (INW / 32), I_OUT = 16 * 32;
    for (int it = gw; it < I_IN + I_OUT; it += NGW) {
        if (it < I_IN) p0_transpose_item<1>(p.w_in, INW, (bf16_t*)(p.ws + WS_WIN), scr, it, lane);
        else p0_transpose_item<0>(p.w_out, DM, (bf16_t*)(p.ws + WS_WOUT), scr, it - I_IN, lane);
    }
    bf16_t* XN = (bf16_t*)(p.ws + WS_MIXED);
    const int gwx = (vcu - 21) * NWAVES + wave, NGWX = (G - 21) * NWAVES;
    for (int m0 = (G > 42 ? gwx : gw) * 4; m0 < NROWS && (G <= 42 || vcu >= 21); m0 += (G > 42 ? NGWX : NGW) * 4) {
        f32x4 v[4][4];
#pragma unroll
        for (int r = 0; r < 4; ++r) { const int m = m0 + r < NROWS ? m0 + r : NROWS - 1; const float* xr = m < T ? p.x + (size_t)m * DM : p.meta + (size_t)(m - T) * DM;
#pragma unroll
            for (int j = 0; j < 4; ++j) v[r][j] = ((const f32x4*)xr)[lane + 64 * j]; }
#pragma unroll
        for (int r = 0; r < 4; ++r) { const int m = m0 + r; float s = 0.f;
#pragma unroll
            for (int j = 0; j < 4; ++j) s += (v[r][j][0] * v[r][j][0] + v[r][j][1] * v[r][j][1]) + (v[r][j][2] * v[r][j][2] + v[r][j][3] * v[r][j][3]);
#pragma unroll
            for (int o = 1; o < 64; o <<= 1) s += shx(s, o, lane);
            const float rs = rsqrtf(s * (1.0f / DM) + EPS);
            if (m < NROWS) {
#pragma unroll
                for (int j = 0; j < 4; ++j) { const f32x4 g = ((const f32x4*)p.g_attn)[lane + 64 * j]; const f32x4 y = v[r][j] * rs * g; u32x2 w; w.x = pk2(y[0], y[1]); w.y = pk2(y[2], y[3]); ((u32x2*)(XN + (size_t)m * DM))[lane + 64 * j] = w; } } }
    }
    if (vcu == 0 && tid < 48) { const int i = tid; const bool a64 = i < 32; const int f = a64 ? i : i - 32; const float inv = powf(10000.0f, -(float)(2 * f) / (a64 ? 64.0f : 32.0f)); const float ang = 16.0f * inv;
        ((float2*)(p.ws + WS_ROT))[i] = make_float2(cosf(ang), sinf(ang)); ((float*)(p.ws + WS_ROT))[96 + i] = inv * 0.15915494309189535f; }
}
__device__ __forceinline__ void ph1(const Ctx& c) {
    const P& p = *c.pp;
    pg8::RowOrder S; S.init(T, INW, c.G, c.bx, p.ws + WS_MIXED, p.ws + WS_WIN);
    pg8::EpiQKV E{c.pp};
    { const int t = c.wave * 64 + fresh_lane(); LAS float* tab = (LAS float*)(c.lds + TAB_EPI);
      if (t < 336) tab[t] = t < 64 ? p.g_q_swa[t] : t < 128 ? p.g_k_swa[t - 64] : t < 160 ? p.g_q_diff[t - 128] : t < 192 ? p.g_k_diff[t - 160] : ((const float*)(p.ws + WS_ROT))[t - 192];
      __syncthreads(); }
    pg8::gemm_phase<pg8::EpiQKV, pg8::RowOrder>(c.lds + RING_OFF, S, E, c.wave);
}
__device__ __forceinline__ void ph2(const Ctx& c) { att::phase(*c.pp, c.lds + RING_OFF, c.G, c.vcu, c.wave); }
__device__ __forceinline__ void ph3(const Ctx& c) {
    const P& p = *c.pp;
    pg8::RowOrder S; S.init(T, DM, c.G, c.bx, p.ws + WS_MIXED, p.ws + WS_WOUT);
    pg8::EpiO E{(bf16_t*)p.out};
    pg8::gemm_phase<pg8::EpiO, pg8::RowOrder>(c.lds + RING_OFF, S, E, c.wave);
}
constexpr int R_AP = 2064;
constexpr int R_AH = 0, R_AL = 16 * R_AP, R_PART = 32 * R_AP, R_HIST = R_PART + 16384, R_SEL = R_HIST + 256, R_GATE = R_SEL + 4096;
static_assert(R_GATE + 4096 <= RING_BYTES, "router LDS");
struct RRows { f32x4 x[2][4]; u32x2 o[2][4]; };
__device__ __forceinline__ void r_load(const P& p, RRows& r, int tok0, int lane) {
#pragma unroll
    for (int rr = 0; rr < 2; ++rr) { const f32x4* xr = (const f32x4*)(p.x + (size_t)(tok0 + rr) * DM); const u32x2* orow = (const u32x2*)((const bf16_t*)p.out + (size_t)(tok0 + rr) * 2048);
#pragma unroll
        for (int j = 0; j < 4; ++j) { r.x[rr][j] = xr[lane + 64 * j]; r.o[rr][j] = orow[lane + 64 * j]; } }
}
__device__ __forceinline__ void r_tile(const Ctx& c, const RRows& r, int tokw  , int slot0  , const f32x4 (&gq)[4], const bf16x8 (&bh)[4][2], const bf16x8 (&bl)[4][2], float bias) {
    const P& p = *c.pp; const int wave = c.wave, lane = fresh_lane(); LAS unsigned char* L = c.lds + RING_OFF;
    unsigned char* V = p.ws + WS_V;
#pragma unroll
    for (int rr = 0; rr < 2; ++rr) { f32x4 h[4]; float s = 0.f;
#pragma unroll
        for (int j = 0; j < 4; ++j) { const u32x2 w = r.o[rr][j]; h[j] = r.x[rr][j] + (f32x4){__uint_as_float(w.x << 16), __uint_as_float(w.x & 0xffff0000u), __uint_as_float(w.y << 16), __uint_as_float(w.y & 0xffff0000u)};
            s += (h[j][0] * h[j][0] + h[j][1] * h[j][1]) + (h[j][2] * h[j][2] + h[j][3] * h[j][3]); }
        s = allsum64(s);
        const float rs = rsqrtf(s * (1.0f / DM) + EPS);
#pragma unroll
        for (int j = 0; j < 4; ++j) { u32x2 hb; hb.x = pg8::cvt_pk_bf16(h[j][0], h[j][1]); hb.y = pg8::cvt_pk_bf16(h[j][2], h[j][3]); ((u32x2*)((bf16_t*)p.out + (size_t)(tokw + rr) * 2048))[lane + 64 * j] = hb; }
#pragma unroll
        for (int j = 0; j < 4; ++j) { const f32x4 v = h[j] * rs * gq[j]; u32x2 wh, wl; wh.x = pg8::cvt_pk_bf16(v[0], v[1]); wh.y = pg8::cvt_pk_bf16(v[2], v[3]);
            const f32x4 d = v - (f32x4){__uint_as_float(wh.x << 16), __uint_as_float(wh.x & 0xffff0000u), __uint_as_float(wh.y << 16), __uint_as_float(wh.y & 0xffff0000u)};
            wl.x = pg8::cvt_pk_bf16(d[0], d[1]); wl.y = pg8::cvt_pk_bf16(d[2], d[3]);
            ((unsigned*)(V + (size_t)(tokw + rr) * DM))[lane + 64 * j] = pg8::pk4_fp8(8.0f * v[0], 8.0f * v[1], 8.0f * v[2], 8.0f * v[3]);
            *(LAS u32x2*)(L + R_AH + (2 * wave + rr) * R_AP + (lane + 64 * j) * 8) = wh; *(LAS u32x2*)(L + R_AL + (2 * wave + rr) * R_AP + (lane + 64 * j) * 8) = wl; } }
    __syncthreads();
    f32x4 acc[2], ahh[2], ahl[2], alh[2];
#pragma unroll
    for (int eb = 0; eb < 2; ++eb) { ahh[eb] = (f32x4){0.f, 0.f, 0.f, 0.f}; ahl[eb] = ahh[eb]; alh[eb] = ahh[eb]; }
#pragma unroll
    for (int s = 0; s < 4; ++s) { const int off = (lane & 15) * R_AP + (128 * wave + 32 * s + 8 * (lane >> 4)) * 2;
        const bf16x8 ah = *(const LAS bf16x8*)(L + R_AH + off), al = *(const LAS bf16x8*)(L + R_AL + off);
#pragma unroll
        for (int eb = 0; eb < 2; ++eb) { ahh[eb] = __builtin_amdgcn_mfma_f32_16x16x32_bf16(ah, bh[s][eb], ahh[eb], 0, 0, 0); ahl[eb] = __builtin_amdgcn_mfma_f32_16x16x32_bf16(ah, bl[s][eb], ahl[eb], 0, 0, 0);
            alh[eb] = __builtin_amdgcn_mfma_f32_16x16x32_bf16(al, bh[s][eb], alh[eb], 0, 0, 0); } }
#pragma unroll
    for (int eb = 0; eb < 2; ++eb) acc[eb] = ahh[eb] + (ahl[eb] + alh[eb]);
    LAS float* part = (LAS float*)(L + R_PART);
#pragma unroll
    for (int eb = 0; eb < 2; ++eb)
#pragma unroll
        for (int q = 0; q < 4; ++q) part[(wave * 16 + (lane >> 4) * 4 + q) * 32 + 16 * eb + (lane & 15)] = acc[eb][q];
    __syncthreads();
    const int tl = 2 * wave + (lane >> 5), e = lane & 31; float lg = bias;
#pragma unroll
    for (int w = 0; w < 8; ++w) lg += part[(w * 16 + tl) * 32 + e];
    float cur = lg, tv0 = 0.f, tv1 = 0.f, tv2 = 0.f, tv3 = 0.f; int ti0 = 0, ti1 = 0, ti2 = 0, ti3 = 0;
#pragma unroll
    for (int k = 0; k < TOPK; ++k) {
        const float bv = allmax32(cur); const unsigned long long mk = __builtin_amdgcn_ballot_w64(cur == bv);
        const int i0 = (int)__builtin_ctzll(mk | (1ull << 32)), i1 = (int)__builtin_ctzll((mk >> 32) | (1ull << 32)); const int bi = (lane >> 5) ? i1 : i0;
        if (k == 0) { tv0 = bv; ti0 = bi; } if (k == 1) { tv1 = bv; ti1 = bi; } if (k == 2) { tv2 = bv; ti2 = bi; } if (k == 3) { tv3 = bv; ti3 = bi; }
        if (e == bi) cur = -INFINITY; }
    const float e1 = __expf(tv1 - tv0), e2 = __expf(tv2 - tv0), e3 = __expf(tv3 - tv0); const float inv = 1.0f / (1.0f + e1 + e2 + e3);
    if (e < 4) { const int sel = e == 0 ? ti0 : e == 1 ? ti1 : e == 2 ? ti2 : ti3; const float gg = (e == 0 ? 1.0f : e == 1 ? e1 : e == 2 ? e2 : e3) * inv;
        LAS int* lsel = (LAS int*)(L + R_SEL); LAS float* lgate = (LAS float*)(L + R_GATE); LAS int* lhist = (LAS int*)(L + R_HIST);
        lsel[(slot0 + tl) * 4 + e] = sel; lgate[(slot0 + tl) * 4 + e] = gg; atomicAdd((int*)(lhist + sel), 1); }
}
__device__ __forceinline__ void ph4(const Ctx& c) {
    const P& p = *c.pp; const int wave = c.wave, lane = fresh_lane(), tid = wave * 64 + lane; LAS unsigned char* L = c.lds + RING_OFF;
    LAS int* lhist = (LAS int*)(L + R_HIST); LAS int* lbase = lhist + 32; LAS int* lsel = (LAS int*)(L + R_SEL); LAS float* lgate = (LAS float*)(L + R_GATE);
    unsigned* counts = c.ctl + CW_COUNT;
    bf16x8 bh[4][2], bl[4][2]; f32x4 gq[4];
    { const bf16_t* wh = (const bf16_t*)(p.ws + WS_WRT); const bf16_t* wl = wh + NE * DM;
#pragma unroll
      for (int s = 0; s < 4; ++s)
#pragma unroll
          for (int eb = 0; eb < 2; ++eb) { const size_t o = (size_t)(16 * eb + (lane & 15)) * DM + 128 * wave + 32 * s + 8 * (lane >> 4); bh[s][eb] = *(const bf16x8*)(wh + o); bl[s][eb] = *(const bf16x8*)(wl + o); }
#pragma unroll
      for (int j = 0; j < 4; ++j) gq[j] = ((const f32x4*)p.g_ffn)[lane + 64 * j]; }
    const float bias = p.b_router[lane & 31];
    for (int ch = c.bx; ch < T / 256; ch += c.G) {
        const int t0 = ch * 256;
        if (tid < NE) lhist[tid] = 0;
        RRows ra, rb; r_load(p, ra, t0 + 2 * wave, lane);
        for (int tile = 0; tile < 16; tile += 2) {
            r_load(p, rb, t0 + 16 * (tile + 1) + 2 * wave, lane);
            r_tile(c, ra, t0 + 16 * tile + 2 * wave, 16 * tile, gq, bh, bl, bias);
            if (tile + 2 < 16) r_load(p, ra, t0 + 16 * (tile + 2) + 2 * wave, lane);
            r_tile(c, rb, t0 + 16 * (tile + 1) + 2 * wave, 16 * (tile + 1), gq, bh, bl, bias);
        }
        __syncthreads();
        if (tid < NE) { lbase[tid] = (int)atomicAdd(&counts[tid], (unsigned)lhist[tid]); lhist[tid] = 0; }
        __syncthreads();
        int* extok = (int*)(p.ws + WS_EXTOK); float* exgate = (float*)(p.ws + WS_EXGATE);
        for (int i = tid; i < 256 * 4; i += NWAVES * 64) { const int e = lsel[i]; const int pos = lbase[e] + atomicAdd((int*)(lhist + e), 1);
            extok[e * 65536 + pos] = (t0 + (i >> 2)) * 4 + (i & 3); exgate[e * 65536 + pos] = lgate[i]; }
        __syncthreads();
    }
}
__device__ __forceinline__ int moe_tables(const Ctx& c) {
    LAS int* pstart = (LAS int*)(c.lds + TAB_PSTART); LAS int* cnts = (LAS int*)(c.lds + TAB_CNT); LAS unsigned char* pexp = (LAS unsigned char*)(c.lds + TAB_PEXP);
    const int tid_ = c.wave * 64 + fresh_lane();
    __syncthreads();
    if (c.wave == 0) {
        const int l_ = tid_; const int cc = l_ < NE ? (int)__hip_atomic_load(c.ctl + CW_COUNT + l_, RLX_AGENT) : 0; const int np = (cc + 255) >> 8; int inc = np;
#pragma unroll
        for (int o = 1; o < NE; o <<= 1) { const int t = __builtin_amdgcn_ds_bpermute(((l_ - o) & 63) << 2, inc); if (l_ >= o) inc += t; }
        if (l_ < NE) { cnts[l_] = cc; pstart[l_] = inc - np; if (l_ == NE - 1) pstart[NE] = inc; } }
    __syncthreads();
    const int npan = pstart[NE];
    for (int pnl = tid_; pnl < npan; pnl += NWAVES * 64) { int e = 0;
#pragma unroll
        for (int st = 16; st >= 1; st >>= 1) if (pstart[e + st] <= pnl) e += st;
        pexp[pnl] = (unsigned char)e; }
    __syncthreads();
    return __builtin_amdgcn_readfirstlane(npan);
}
__device__ __forceinline__ void ph5(const Ctx& c) {
    const P& p = *c.pp; const int npan = moe_tables(c);
    LAS int* pstart = (LAS int*)(c.lds + TAB_PSTART); LAS int* cnts = (LAS int*)(c.lds + TAB_CNT); LAS unsigned char* pexp = (LAS unsigned char*)(c.lds + TAB_PEXP);
    pg8::MoeOrder<8, true> S{c.G, c.vcu, npan, (const char*)(p.ws + WS_V), (const char*)(p.ws + WS_W1T), (size_t)2048 * DM, (const int*)(p.ws + WS_EXTOK), pstart, cnts, pexp};
    pg8::EpiSwiglu E{p.b1, p.ws + WS_ACT};
    pg8::gemm_phase<pg8::EpiSwiglu, pg8::MoeOrder<8, true>>(c.lds + RING_OFF, S, E, c.wave);
}
__device__ __forceinline__ void ph6(const Ctx& c) {
    const P& p = *c.pp; const int npan = moe_tables(c);
    LAS int* pstart = (LAS int*)(c.lds + TAB_PSTART); LAS int* cnts = (LAS int*)(c.lds + TAB_CNT); LAS unsigned char* pexp = (LAS unsigned char*)(c.lds + TAB_PEXP);
    pg8::MoeOrder<4, false> S{c.G, c.vcu, npan, (const char*)(p.ws + WS_ACT), (const char*)(p.ws + WS_W2T), (size_t)DM * DM, (const int*)(p.ws + WS_EXTOK), pstart, cnts, pexp};
    pg8::EpiMoe2 E{p.b2, (const int*)(p.ws + WS_EXTOK), (const float*)(p.ws + WS_EXGATE), (unsigned char*)p.out, p.ws + WS_YS3};
    pg8::gemm_phase<pg8::EpiMoe2, pg8::MoeOrder<4, false>>(c.lds + RING_OFF, S, E, c.wave);
}
struct R7 { u32x4 h0, h1v, y[4]; };
__device__ __forceinline__ void p7_load(const P& p, int t, int lane, R7& r) {
    const unsigned char* row = (const unsigned char*)p.out + (size_t)t * 4096; const unsigned char* ys = p.ws + WS_YS3;
    r.h0 = *(const u32x4*)(row + 32 * lane); r.h1v = *(const u32x4*)(row + 32 * lane + 16); r.y[0] = *(const u32x4*)(row + 2048 + 16 * lane);
#pragma unroll
    for (int k = 0; k < 3; ++k) r.y[k + 1] = *(const u32x4*)(ys + ((size_t)t * 3 + k) * DM + 16 * lane);
}
__device__ __forceinline__ void p7_finish(const P& p, int t, int lane, const R7& r) {
    float o[16];
#pragma unroll
    for (int q = 0; q < 4; ++q) { o[2 * q] = __uint_as_float(r.h0[q] << 16); o[2 * q + 1] = __uint_as_float(r.h0[q] & 0xffff0000u); o[8 + 2 * q] = __uint_as_float(r.h1v[q] << 16); o[8 + 2 * q + 1] = __uint_as_float(r.h1v[q] & 0xffff0000u); }
#pragma unroll
    for (int q = 0; q < 4; ++q) { float s0 = 0.f, s1 = 0.f, s2 = 0.f, s3 = 0.f;
#pragma unroll
        for (int k = 0; k < 4; ++k) { const auto lo = __builtin_amdgcn_cvt_pk_f32_fp8((int)r.y[k][q], false), hi = __builtin_amdgcn_cvt_pk_f32_fp8((int)r.y[k][q], true); s0 += lo[0]; s1 += lo[1]; s2 += hi[0]; s3 += hi[1]; }
        o[4 * q] += s0 * (1.0f / 64.0f); o[4 * q + 1] += s1 * (1.0f / 64.0f); o[4 * q + 2] += s2 * (1.0f / 64.0f); o[4 * q + 3] += s3 * (1.0f / 64.0f); }
    asm volatile("" ::: "memory");
    f32x4* dst = (f32x4*)(p.out + (size_t)t * DM + 16 * lane);
#pragma unroll
    for (int q = 0; q < 4; ++q) dst[q] = (f32x4){o[4 * q], o[4 * q + 1], o[4 * q + 2], o[4 * q + 3]};
}
__device__ __forceinline__ void ph7(const Ctx& c) {
    const P& p = *c.pp; const int gw = c.bx * NWAVES + c.wave, NGW = c.G * NWAVES, lane = fresh_lane();
    R7 a, b; int t = gw;
    if (t < T) p7_load(p, t, lane, a);
    while (t < T) {
        const int t1 = t + NGW; if (t1 < T) p7_load(p, t1, lane, b);
        p7_finish(p, t, lane, a);
        if (t1 >= T) break;
        const int t2 = t1 + NGW; if (t2 < T) p7_load(p, t2, lane, a);
        p7_finish(p, t1, lane, b);
        t = t2;
    }
}
struct EpiNull8 { static constexpr bool PERM = true; static constexpr bool HAS_PREFETCH = false; static constexpr unsigned SCALE_W = 0x7c7c7c7cu, SCALE_A = 0x7c7c7c7cu;
    __device__ __forceinline__ void operator()(const f32x4 (&acc)[2][2][4][2], const pg8::Unit&, int, int, int, int) const {
#pragma unroll
        for (int a = 0; a < 2; ++a)
#pragma unroll
            for (int b = 0; b < 2; ++b)
#pragma unroll
                for (int m = 0; m < 4; ++m)
#pragma unroll
                    for (int n = 0; n < 2; ++n) asm volatile("" :: "v"(acc[a][b][m][n])); } };
__device__ __forceinline__ void ph5null(const Ctx& c) {
    const P& p = *c.pp; const int npan = moe_tables(c);
    LAS int* pstart = (LAS int*)(c.lds + TAB_PSTART); LAS int* cnts = (LAS int*)(c.lds + TAB_CNT); LAS unsigned char* pexp = (LAS unsigned char*)(c.lds + TAB_PEXP);
    pg8::MoeOrder<8, true> S{c.G, c.vcu, npan, (const char*)(p.ws + WS_V), (const char*)(p.ws + WS_W1T), (size_t)2048 * DM, (const int*)(p.ws + WS_EXTOK), pstart, cnts, pexp};
    EpiNull8 E; pg8::gemm_phase<EpiNull8, pg8::MoeOrder<8, true>>(c.lds + RING_OFF, S, E, c.wave);
}
__device__ __forceinline__ void ph6null(const Ctx& c) {
    const P& p = *c.pp; const int npan = moe_tables(c);
    LAS int* pstart = (LAS int*)(c.lds + TAB_PSTART); LAS int* cnts = (LAS int*)(c.lds + TAB_CNT); LAS unsigned char* pexp = (LAS unsigned char*)(c.lds + TAB_PEXP);
    pg8::MoeOrder<4, false> S{c.G, c.vcu, npan, (const char*)(p.ws + WS_ACT), (const char*)(p.ws + WS_W2T), (size_t)DM * DM, (const int*)(p.ws + WS_EXTOK), pstart, cnts, pexp};
    EpiNull8 E; pg8::gemm_phase<EpiNull8, pg8::MoeOrder<4, false>>(c.lds + RING_OFF, S, E, c.wave);
}
#ifndef PROBE_REP
#define PROBE_REP -1
#endif

__global__ void __launch_bounds__(NWAVES * 64, 2) mk_fwd(Args args) {
    extern __shared__ __attribute__((aligned(16))) unsigned char lds_raw[];
    Ctx c; c.pp = &args.p; c.lds = (LAS unsigned char*)lds_raw;
    c.wave = __builtin_amdgcn_readfirstlane((int)(threadIdx.x >> 6));
    c.G = gridDim.x; c.bx = blockIdx.x; c.vcu = (c.G % 8 == 0) ? (c.bx % 8) * (c.G / 8) + c.bx / 8 : c.bx;
    c.ctl = (unsigned*)(args.p.ws + WS_CTL);
    for (int u = c.wave * 64 + fresh_lane(); u < (LDS_BYTES - LDSCTL_OFF) / 4; u += NWAVES * 64) ((LAS unsigned*)(c.lds + LDSCTL_OFF))[u] = 0u;
    __syncthreads();
    const int lo = args.ph_lo, hi = args.ph_hi;
    XcdBarrier bar; bar.bar = c.ctl + CW_BAR; bar.x = 0; bar.st = nullptr; bar.wave = c.wave;
    if (hi - lo > 1) bar = xcd_barrier_post(c.ctl + CW_BAR, (volatile LAS unsigned*)(c.lds + MISC_OFF) + 8, c.wave);
#define IN(k) (lo <= (k) && (k) < hi)
#define SEAM(k) do { if (IN(k) && IN((k) + 1)) xcd_barrier(bar); } while (0)
#define PH(k, f) do { if (IN(k)) { f(c); if (PROBE_REP == (k)) { __syncthreads(); f(c); } } } while (0)
#if PROBE_REP == 100
    if (IN(1)) { { pg8::RowOrder S; S.init(T, INW, c.G, c.bx, args.p.ws + WS_MIXED, args.p.ws + WS_WIN); pg8::EpiNull<true> E; pg8::gemm_phase<pg8::EpiNull<true>, pg8::RowOrder>(c.lds + RING_OFF, S, E, c.wave); }
                 { pg8::RowOrder S; S.init(T, DM, c.G, c.bx, args.p.ws + WS_MIXED, args.p.ws + WS_WOUT); pg8::EpiNull<false> E; pg8::gemm_phase<pg8::EpiNull<false>, pg8::RowOrder>(c.lds + RING_OFF, S, E, c.wave); } __syncthreads(); }
#endif
    PH(0, ph0); SEAM(0);
    PH(1, ph1); SEAM(1);
    PH(2, ph2); SEAM(2);
    PH(3, ph3); SEAM(3);
    PH(4, ph4); SEAM(4);
#if PROBE_REP == 101
    if (IN(5)) { ph5null(c); __syncthreads(); }
#endif
#if PROBE_REP == 102
    if (IN(5)) { ph6null(c); __syncthreads(); }
#endif
    PH(5, ph5); SEAM(5);
    PH(6, ph6); SEAM(6);
    PH(7, ph7);
#undef IN
#undef SEAM
#undef PH
}

extern "C" void kernel_launch(void* const* d_in, const int* in_sizes, int n_in, void* d_out, int out_size, void* d_ws, size_t ws_size, hipStream_t stream) {
    static int grid = 0;
    if (grid == 0) {
        if (n_in != 22 || out_size != T * DM || ws_size < WS_END) { fprintf(stderr, "kernel_launch: unexpected shapes (n_in %d out %d ws %zu)\n", n_in, out_size, ws_size); grid = -1; return; }
        int dev = 0, cus = 0, per_cu = 0;
        if (hipGetDevice(&dev) != hipSuccess || hipDeviceGetAttribute(&cus, hipDeviceAttributeMultiprocessorCount, dev) != hipSuccess) { grid = -1; return; }
        if (hipFuncSetAttribute((const void*)mk_fwd, hipFuncAttributeMaxDynamicSharedMemorySize, LDS_BYTES) != hipSuccess) { fprintf(stderr, "kernel_launch: hipFuncSetAttribute failed\n"); grid = -1; return; }
        if (hipOccupancyMaxActiveBlocksPerMultiprocessor(&per_cu, (const void*)mk_fwd, NWAVES * 64, LDS_BYTES) != hipSuccess || per_cu < 1) fprintf(stderr, "kernel_launch: occupancy query says %d\n", per_cu);
        (void)hipGetLastError();
        grid = cus;
    }
    if (grid < 0) return;
    Args a{};
    const float** f = (const float**)&a.p;
    for (int i = 0; i < 22; ++i) f[i] = (const float*)d_in[i];
    a.p.out = (float*)d_out; a.p.ws = (unsigned char*)d_ws;
    const P& p = a.p;
    (void)hipMemsetAsync((char*)d_ws + WS_CTL, 0, 32768, stream);
#define MK(lo_, hi_) do { a.ph_lo = (lo_); a.ph_hi = (hi_); hipLaunchKernelGGL(mk_fwd, dim3(grid), dim3(NWAVES * 64), LDS_BYTES, stream, a); } while (0)
#if ONE_LAUNCH
    MK(0, NPHASE);
#else
    MK(0, 1);
#if OPT_INPROJ
    MK(1, 2);
#else
    hipLaunchKernelGGL(k_rstd, dim3((NROWS + 3) / 4), dim3(256), 0, stream, p);
    hipLaunchKernelGGL(k_inproj_naive, dim3((NROWS + 63) / 64, 36), dim3(256), 0, stream, p);
#endif
#if OPT_ATTN
    MK(2, 3);
#else
    hipLaunchKernelGGL(k_swa_naive, dim3(NB * 8 * SEQ / 256), dim3(256), 0, stream, p);
    hipLaunchKernelGGL(k_diff_naive, dim3(NB * 8 * 16), dim3(256), 0, stream, p);
#endif
#if 1
    MK(3, 4);
#else
    hipLaunchKernelGGL(k_sgemm<0>, dim3(T / 64, DM / 64), dim3(256), 0, stream, p);
#endif
#if 1
    MK(4, 5);
#else
    hipLaunchKernelGGL(k_route, dim3(T / 64), dim3(256), 0, stream, p);
#endif
#if 1
    MK(5, 6); MK(6, 7);
#else
    hipLaunchKernelGGL(k_sgemm<1>, dim3((T * 4 + NE * 255 + 63) / 64 + 4, DFF / 64), dim3(256), 0, stream, p);
    hipLaunchKernelGGL(k_sgemm<2>, dim3((T * 4 + NE * 255 + 63) / 64 + 4, DM / 64), dim3(256), 0, stream, p);
#endif
#if 1
    MK(7, 8);
#else
    hipLaunchKernelGGL(k_combine, dim3(T * DM / 4 / 256), dim3(256), 0, stream, p);
#endif
#endif
#undef MK
}
```
